# Optimizing an MI355X kernel written in HIP

```python
import jax, jax.numpy as jnp
from jax import lax
import numpy as np

D_MODEL = 1024
BATCH = 2
SEQ = 16384
DEPTH = 2

GRID_W = 64
CTX_LEN = 256
HEAD_DIM = 64
ATTN_Q_HEADS = 8
ATTN_KV_HEADS = 2
GQA_GROUP = ATTN_Q_HEADS // ATTN_KV_HEADS
WINDOW = 128
BLOCK = 128
ATTN_DIM = ATTN_Q_HEADS * HEAD_DIM
KV_DIM = ATTN_KV_HEADS * HEAD_DIM
GM_GROUPS = 8
GM_DIM = GM_GROUPS * HEAD_DIM
CHUNK = 128
IN_DIM_EVEN = ATTN_DIM + 2 * KV_DIM + 2 * GM_DIM
MIX_DIM_EVEN = ATTN_DIM + GM_DIM
SPLITS_EVEN = [ATTN_DIM, ATTN_DIM + KV_DIM, ATTN_DIM + 2 * KV_DIM, ATTN_DIM + 2 * KV_DIM + GM_DIM]
CONV_DIM = D_MODEL
CONV_WIDTH = 3
D_FF = -(-8 * D_MODEL // (3 * 256)) * 256
ROPE_THETA = 10000.0
RMS_EPS = 1e-6
LN_EPS = 1e-5
NEG_INF = -1e30
N_EVEN = (DEPTH + 1) // 2
N_ODD = DEPTH // 2

kernel_name = "hybrid_swa_gmlp_shortconv_dit"


def rms_norm(x, g):
    xf = x.astype(jnp.float32)
    y = xf * lax.rsqrt(jnp.mean(xf * xf, axis=-1, keepdims=True) + RMS_EPS)
    return (y * g.astype(jnp.float32)).astype(x.dtype)


def modulate(x, g, shift, scale):
    return rms_norm(x, g) * (1.0 + scale) + shift


def axial_rope_tables(rows):
    q = HEAD_DIM // 4
    inv = ROPE_THETA ** (-jnp.arange(q, dtype=jnp.float32) / q)
    row = jnp.repeat(jnp.arange(rows, dtype=jnp.float32), GRID_W)
    col = jnp.tile(jnp.arange(GRID_W, dtype=jnp.float32), rows)
    ang = jnp.stack([row[:, None] * inv, col[:, None] * inv], axis=1)
    return jnp.cos(ang), jnp.sin(ang)


def apply_axial_rope(x, cos, sin):
    q = HEAD_DIM // 4
    xf = x.astype(jnp.float32).reshape(*x.shape[:-1], 2, 2, q)
    a, b = xf[..., 0, :], xf[..., 1, :]
    cc, ss = cos[None, :, None], sin[None, :, None]
    out = jnp.stack([a * cc - b * ss, a * ss + b * cc], axis=-2)
    return out.reshape(x.shape).astype(x.dtype)


def window_attention(q, k, v, kc, vc, sink):
    B, S = q.shape[0], q.shape[1]
    nb = S // BLOCK
    scale = HEAD_DIM ** -0.5
    qb = q.reshape(B, nb, BLOCK, ATTN_KV_HEADS, GQA_GROUP, HEAD_DIM)
    pad = ((0, 0), (BLOCK, BLOCK), (0, 0), (0, 0))
    kp = jnp.pad(k, pad).reshape(B, nb + 2, BLOCK, ATTN_KV_HEADS, HEAD_DIM)
    vp = jnp.pad(v, pad).reshape(B, nb + 2, BLOCK, ATTN_KV_HEADS, HEAD_DIM)
    kw = jnp.concatenate([kp[:, :-2], kp[:, 1:-1], kp[:, 2:]], axis=2)
    vw = jnp.concatenate([vp[:, :-2], vp[:, 1:-1], vp[:, 2:]], axis=2)
    s_win = jnp.einsum('bnqkgd,bnrkd->bnkgqr', qb, kw, preferred_element_type=jnp.float32) * scale
    qpos = jnp.arange(nb)[:, None] * BLOCK + jnp.arange(BLOCK)[None, :]
    kpos = jnp.arange(nb)[:, None] * BLOCK + jnp.arange(3 * BLOCK)[None, :] - BLOCK
    valid = (jnp.abs(qpos[:, :, None] - kpos[:, None, :]) <= WINDOW) \
        & (kpos >= 0)[:, None, :] & (kpos < S)[:, None, :]
    s_win = jnp.where(valid[None, :, None, None], s_win, NEG_INF)
    s_ctx = jnp.einsum('bnqkgd,blkd->bnkgql', qb, kc, preferred_element_type=jnp.float32) * scale
    s_sink = jnp.broadcast_to(
        sink.astype(jnp.float32).reshape(ATTN_KV_HEADS, GQA_GROUP)[None, None, :, :, None, None],
        s_win.shape[:-1] + (1,))
    p = jax.nn.softmax(jnp.concatenate([s_win, s_ctx, s_sink], axis=-1), axis=-1)
    nw = 3 * BLOCK
    L = kc.shape[1]
    p_win = p[..., :nw].astype(v.dtype)
    p_ctx = p[..., nw:nw + L].astype(v.dtype)
    o = jnp.einsum('bnkgqr,bnrkd->bnqkgd', p_win, vw) + jnp.einsum('bnkgql,blkd->bnqkgd', p_ctx, vc)
    return o.reshape(B, S, ATTN_DIM)


def context_attention(qc, kc, vc, sink):
    B, L = qc.shape[0], qc.shape[1]
    qg = qc.reshape(B, L, ATTN_KV_HEADS, GQA_GROUP, HEAD_DIM)
    s = jnp.einsum('blkgd,bmkd->bkglm', qg, kc, preferred_element_type=jnp.float32) * HEAD_DIM ** -0.5
    s_sink = jnp.broadcast_to(
        sink.astype(jnp.float32).reshape(ATTN_KV_HEADS, GQA_GROUP)[None, :, :, None, None],
        s.shape[:-1] + (1,))
    p = jax.nn.softmax(jnp.concatenate([s, s_sink], axis=-1), axis=-1)[..., :L].astype(vc.dtype)
    o = jnp.einsum('bkglm,bmkd->blkgd', p, vc)
    return o.reshape(B, L, ATTN_DIM)


def chunk_gating(u, v, v_norm, ws, bs):
    B, N, _ = v.shape
    nc = N // CHUNK
    vf = v.astype(jnp.float32).reshape(B, N, GM_GROUPS, HEAD_DIM)
    mu = jnp.mean(vf, axis=-1, keepdims=True)
    var = jnp.mean(jnp.square(vf - mu), axis=-1, keepdims=True)
    vn = ((vf - mu) * lax.rsqrt(var + LN_EPS) * v_norm.astype(jnp.float32).reshape(GM_GROUPS, HEAD_DIM)).astype(v.dtype)
    vn = vn.reshape(B, nc, CHUNK, GM_GROUPS, HEAD_DIM)
    s = jnp.einsum('gij,bnjgd->bnigd', ws, vn) + bs.T[None, None, :, :, None]
    return u * s.reshape(B, N, GM_DIM)


def even_mixer(h, hc, w_in, sink, v_norm, ws, bs, w_out, cos, sin, ctx_out):
    B, S, _ = h.shape
    L = hc.shape[1]
    q, k, v, u, gv = jnp.split(h @ w_in, SPLITS_EVEN, axis=-1)
    q = apply_axial_rope(q.reshape(B, S, ATTN_Q_HEADS, HEAD_DIM), cos, sin)
    k = apply_axial_rope(k.reshape(B, S, ATTN_KV_HEADS, HEAD_DIM), cos, sin)
    v = v.reshape(B, S, ATTN_KV_HEADS, HEAD_DIM)
    if ctx_out:
        qc, kc, vc, uc, gvc = jnp.split(hc @ w_in, SPLITS_EVEN, axis=-1)
    else:
        kc, vc = jnp.split(hc @ w_in[:, ATTN_DIM:ATTN_DIM + 2 * KV_DIM], 2, axis=-1)
    kc = kc.reshape(B, L, ATTN_KV_HEADS, HEAD_DIM)
    vc = vc.reshape(B, L, ATTN_KV_HEADS, HEAD_DIM)
    o_attn = window_attention(q, k, v, kc, vc, sink)
    o_gm = chunk_gating(u, gv, v_norm, ws, bs)
    y = jnp.concatenate([o_attn, o_gm], axis=-1) @ w_out
    yc = None
    if ctx_out:
        oc_attn = context_attention(qc.reshape(B, L, ATTN_Q_HEADS, HEAD_DIM), kc, vc, sink)
        oc_gm = chunk_gating(uc, gvc, v_norm, ws, bs)
        yc = jnp.concatenate([oc_attn, oc_gm], axis=-1) @ w_out
    return y, yc


def short_conv_mixer(h, w_in, conv_w, w_out):
    bg, cg, hx = jnp.split(h @ w_in, 3, axis=-1)
    y = cg * hx
    yconv = lax.conv_general_dilated(
        y, conv_w[:, None, :].astype(y.dtype), window_strides=(1,),
        padding=[(CONV_WIDTH // 2, CONV_WIDTH // 2)],
        dimension_numbers=('NWC', 'WIO', 'NWC'), feature_group_count=CONV_DIM)
    return (bg * yconv) @ w_out


def swiglu(h, w1, w3, w2):
    return (jax.nn.silu(h @ w1) * (h @ w3)) @ w2


def setup_inputs(seed: int = 0) -> dict:
    key = jax.random.key(seed)
    ks = jax.random.split(key, 24)
    f32 = jnp.float32
    D = D_MODEL
    nrm = lambda k, shape, s: jax.random.normal(k, shape, f32) * s
    return {
        "x": nrm(ks[0], (BATCH, SEQ, D), 1.0),
        "c": nrm(ks[1], (BATCH, D), 1.0),
        "ctx": nrm(ks[2], (BATCH, CTX_LEN, D), 1.0),
        "c_ctx": nrm(ks[3], (D,), 1.0),
        "w_mod": nrm(ks[4], (DEPTH, D, 6 * D), D ** -0.5),
        "b_mod": nrm(ks[5], (DEPTH, 6 * D), 0.02),
        "g_mix_pre": 1.0 + nrm(ks[6], (DEPTH, D), 0.05),
        "g_mix_post": 1.0 + nrm(ks[7], (DEPTH, D), 0.05),
        "g_ffn_pre": 1.0 + nrm(ks[8], (DEPTH, D), 0.05),
        "g_ffn_post": 1.0 + nrm(ks[9], (DEPTH, D), 0.05),
        "ffn_w1": nrm(ks[10], (DEPTH, D, D_FF), D ** -0.5),
        "ffn_w3": nrm(ks[11], (DEPTH, D, D_FF), D ** -0.5),
        "ffn_w2": nrm(ks[12], (DEPTH, D_FF, D), D_FF ** -0.5),
        "a_w_in": nrm(ks[13], (N_EVEN, D, IN_DIM_EVEN), D ** -0.5),
        "a_sink": nrm(ks[14], (N_EVEN, ATTN_Q_HEADS), 0.5),
        "gm_v_norm": 1.0 + nrm(ks[15], (N_EVEN, GM_DIM), 0.05),
        "gm_ws": nrm(ks[16], (N_EVEN, GM_GROUPS, CHUNK, CHUNK), CHUNK ** -0.5),
        "gm_bs": 1.0 + nrm(ks[17], (N_EVEN, GM_GROUPS, CHUNK), 0.1),
        "a_w_out": nrm(ks[18], (N_EVEN, MIX_DIM_EVEN, D), MIX_DIM_EVEN ** -0.5),
        "sc_w_in": nrm(ks[19], (N_ODD, D, 3 * CONV_DIM), D ** -0.5),
        "sc_conv": nrm(ks[20], (N_ODD, CONV_WIDTH, CONV_DIM), CONV_WIDTH ** -0.5),
        "sc_w_out": nrm(ks[21], (N_ODD, CONV_DIM, D), CONV_DIM ** -0.5),
    }


def reference(x, c, ctx, c_ctx, w_mod, b_mod, g_mix_pre, g_mix_post, g_ffn_pre, g_ffn_post,
              ffn_w1, ffn_w3, ffn_w2, a_w_in, a_sink, gm_v_norm, gm_ws, gm_bs, a_w_out,
              sc_w_in, sc_conv, sc_w_out):
    n_tok = x.shape[1]
    rows = n_tok // GRID_W
    cos, sin = axial_rope_tables(rows)
    silu_c = jax.nn.silu(c)
    silu_cc = jax.nn.silu(c_ctx)
    xc = ctx
    for i in range(DEPTH):
        ctx_out = any(j % 2 == 0 for j in range(i + 1, DEPTH))
        ctx_in = (i % 2 == 0) or ctx_out
        mod = (silu_c @ w_mod[i] + b_mod[i])[:, None, :]
        sh_m, sc_m, gt_m, sh_f, sc_f, gt_f = jnp.split(mod, 6, axis=-1)
        h = modulate(x, g_mix_pre[i], sh_m, sc_m)
        hc = None
        if ctx_in:
            mod_c = silu_cc @ w_mod[i] + b_mod[i]
            csh_m, csc_m, cgt_m, csh_f, csc_f, cgt_f = jnp.split(mod_c, 6, axis=-1)
            hc = modulate(xc, g_mix_pre[i], csh_m, csc_m)
        if i % 2 == 0:
            e = i // 2
            y, yc = even_mixer(h, hc, a_w_in[e], a_sink[e], gm_v_norm[e], gm_ws[e], gm_bs[e],
                               a_w_out[e], cos, sin, ctx_out)
        else:
            o = i // 2
            y = short_conv_mixer(h, sc_w_in[o], sc_conv[o], sc_w_out[o])
            yc = short_conv_mixer(hc, sc_w_in[o], sc_conv[o], sc_w_out[o]) if ctx_out else None
        x = x + gt_m * rms_norm(y, g_mix_post[i])
        hf = modulate(x, g_ffn_pre[i], sh_f, sc_f)
        x = x + gt_f * rms_norm(swiglu(hf, ffn_w1[i], ffn_w3[i], ffn_w2[i]), g_ffn_post[i])
        if ctx_out:
            xc = xc + cgt_m * rms_norm(yc, g_mix_post[i])
            hcf = modulate(xc, g_ffn_pre[i], csh_f, csc_f)
            xc = xc + cgt_f * rms_norm(swiglu(hcf, ffn_w1[i], ffn_w3[i], ffn_w2[i]), g_ffn_post[i])
    return x
```

```cpp
#include <hip/hip_runtime.h>
#include <hip/hip_cooperative_groups.h>
#include <cstdio>
#include <cstdint>
namespace cg = cooperative_groups;

namespace pg8 {
#define PG8_LAS __attribute__((address_space(3)))
typedef unsigned short bf16_t;
typedef short bf16x8 __attribute__((ext_vector_type(8)));
typedef float f32x4 __attribute__((ext_vector_type(4)));
typedef unsigned u32x4 __attribute__((ext_vector_type(4)));
constexpr int BM = 256, BK = 64, HALF = 128, HTB = HALF * BK * 2  , STAGE_BYTES = 8 * HTB, NXCD = 8, WGM = 8;

__host__ __device__ __forceinline__ int lds_byte(int r, int c) { const int st = (r >> 4) * 2 + (c >> 5), rr = r & 15, cc = c & 31, ob = rr * 64 + cc * 2; return st * 1024 + (ob ^ (((ob >> 9) & 1) << 5)); }
__host__ __device__ __forceinline__ void stage_rc(int b, int& R, int& C) { const int st = b / 1024, sb = b % 1024, swz = sb ^ (((sb >> 9) & 1) << 5); R = (st >> 1) * 16 + swz / 64; C = (st & 1) * 32 + (swz % 64) / 2; }
__host__ __device__ __forceinline__ int perm32(int rho) { const int n = rho >> 4, i = rho & 15; return 8 * (i >> 2) + 4 * n + (i & 3); }

struct Unit { int pm, pn; };
struct Gemm { const bf16_t* A; const bf16_t* Bt; int M, N, K; };

struct StaticOrder {
    int nM, nN, nwg, G, c, rev, i0, i1;
    __host__ __device__ __forceinline__ void init(int M, int N, int G_, int c_, int rev_ = 0) { nM = M / BM; nN = N / BM; nwg = nM * nN; G = G_; c = c_; rev = (rev_ && (nwg % G_ == 0)) ? nwg / G_ : 0; i0 = 0; i1 = 1 << 30; }
    __host__ __device__ __forceinline__ void window(int a, int b) { i0 = a; i1 = b; }
    __host__ __device__ __forceinline__ bool next(int i_, Unit& u) const {
        const int i = i_ + i0; if (i >= i1) return false;
        if (rev && i >= rev) return false;
        const long L = (long)(rev ? (rev - 1 - i) : i) * G + c; if (L >= nwg) return false;
        int wgid = (int)L; { const int q = nwg / NXCD, r = nwg % NXCD, xcd = wgid % NXCD, off = wgid / NXCD; wgid = (xcd < r ? xcd * (q + 1) : r * (q + 1) + (xcd - r) * q) + off; }
        const int nig = WGM * nN, gid = wgid / nig, fm = gid * WGM, gsz = (nM - fm) < WGM ? (nM - fm) : WGM;
        u.pm = fm + ((wgid % nig) % gsz); u.pn = (wgid % nig) / gsz; return true;
    }
    __device__ __forceinline__ void a_ready(const Unit&) const {}
    __device__ __forceinline__ void done(const Unit&) const {}
};
struct TailOrder {
    int G, c, n;
    __device__ __forceinline__ bool next(int i, Unit& u) const { if (i != 0) return false; const int c0 = (G >= 8) ? G - 5 : G - 2; int k = -1; if (c == c0) k = 0; else if (c == G - 1) k = 1; if (k < 0 || k >= n) return false; u.pm = k; u.pn = 0; return true; }
    __device__ __forceinline__ void a_ready(const Unit&) const {}
    __device__ __forceinline__ void done(const Unit&) const {}
};

typedef float f32x2_t __attribute__((ext_vector_type(2))); typedef __bf16 bf16x2_t __attribute__((ext_vector_type(2)));
__device__ __forceinline__ unsigned cvt_pk_bf16(float lo, float hi) { f32x2_t v = {lo, hi}; bf16x2_t b = __builtin_convertvector(v, bf16x2_t); return __builtin_bit_cast(unsigned, b); }


struct EpiBf16 {
    static constexpr bool PERM = true, AFTER_DRAIN = false;
    bf16_t* O; int ldc;
    __device__ __forceinline__ void operator()(const f32x4 (&acc)[2][2][4][2], const Unit& u, int wr, int wc, int fr, int fq) const {
        const int row0 = u.pm * BM + wr * 64 + fr; const int col0 = u.pn * BM + wc * 32 + 8 * fq;
#pragma unroll
        for (int ai = 0; ai < 2; ++ai)
#pragma unroll
            for (int m = 0; m < 4; ++m) { bf16_t* rowp = O + (size_t)(row0 + ai * HALF + m * 16) * ldc + col0;
#pragma unroll
                for (int bj = 0; bj < 2; ++bj) { const f32x4 v0 = acc[ai][bj][m][0], v1 = acc[ai][bj][m][1];
                    u32x4 w; w.x = cvt_pk_bf16(v0[0], v0[1]); w.y = cvt_pk_bf16(v0[2], v0[3]); w.z = cvt_pk_bf16(v1[0], v1[1]); w.w = cvt_pk_bf16(v1[2], v1[3]);
                    *(u32x4*)(rowp + bj * HALF) = w; } }
    }
};
template <int ACT> struct EpiPair {
    static constexpr bool PERM = true, AFTER_DRAIN = false;
    bf16_t* O; int ldc; int npair; bf16_t* O2; int ldc2;
    __device__ __forceinline__ void operator()(const f32x4 (&acc)[2][2][4][2], const Unit& u, int wr, int wc, int fr, int fq) const {
        const int row0 = u.pm * BM + wr * 64 + fr;
        if (u.pn < npair) {
            const int col0 = u.pn * HALF + wc * 32 + 8 * fq;
#pragma unroll
            for (int ai = 0; ai < 2; ++ai)
#pragma unroll
                for (int m = 0; m < 4; ++m) { bf16_t* rowp = O + (size_t)(row0 + ai * HALF + m * 16) * ldc + col0; float r[8];
#pragma unroll
                    for (int n = 0; n < 2; ++n)
#pragma unroll
                        for (int j = 0; j < 4; ++j) { float a = acc[ai][0][m][n][j]; const float b = acc[ai][1][m][n][j];
                            if (ACT == 1) a = a * __builtin_amdgcn_rcpf(1.0f + __builtin_amdgcn_exp2f(-1.4426950408889634f * a));
                            r[n * 4 + j] = a * b; }
                    u32x4 w; w.x = cvt_pk_bf16(r[0], r[1]); w.y = cvt_pk_bf16(r[2], r[3]); w.z = cvt_pk_bf16(r[4], r[5]); w.w = cvt_pk_bf16(r[6], r[7]);
                    *(u32x4*)rowp = w; }
        } else {
            const int col0 = (u.pn - npair) * BM + wc * 32 + 8 * fq;
#pragma unroll
            for (int ai = 0; ai < 2; ++ai)
#pragma unroll
                for (int m = 0; m < 4; ++m) { bf16_t* rowp = O2 + (size_t)(row0 + ai * HALF + m * 16) * ldc2 + col0;
#pragma unroll
                    for (int bj = 0; bj < 2; ++bj) { const f32x4 v0 = acc[ai][bj][m][0], v1 = acc[ai][bj][m][1];
                        u32x4 w; w.x = cvt_pk_bf16(v0[0], v0[1]); w.y = cvt_pk_bf16(v0[2], v0[3]); w.z = cvt_pk_bf16(v1[0], v1[1]); w.w = cvt_pk_bf16(v1[2], v1[3]);
                        *(u32x4*)(rowp + bj * HALF) = w; } }
        }
    }
};
struct EpiConv {
    static constexpr bool PERM = true, AFTER_DRAIN = false;
    const bf16_t* Y1; bf16_t* Z; const float* cw; int ld; int seq;
    __device__ __forceinline__ void operator()(const f32x4 (&acc)[2][2][4][2], const Unit& u, int wr, int wc, int fr, int fq) const {
        const int row0 = u.pm * BM + wr * 64 + fr;
#pragma unroll
        for (int bj = 0; bj < 2; ++bj) {
            const int col = u.pn * BM + bj * HALF + wc * 32 + 8 * fq;
            const f32x4 w0a = *(const f32x4*)(cw + col), w0b = *(const f32x4*)(cw + col + 4), w1a = *(const f32x4*)(cw + ld + col), w1b = *(const f32x4*)(cw + ld + col + 4),
                        w2a = *(const f32x4*)(cw + 2 * ld + col), w2b = *(const f32x4*)(cw + 2 * ld + col + 4);
#pragma unroll
            for (int ai = 0; ai < 2; ++ai)
#pragma unroll
                for (int m = 0; m < 4; ++m) {
                    const int row = row0 + ai * HALF + m * 16; const int s = row & (seq - 1);
                    const bf16_t* yp = Y1 + (size_t)row * ld + col;
                    const u32x4 y1 = *(const u32x4*)yp;
                    const u32x4 y0 = (s > 0) ? *(const u32x4*)(yp - ld) : (u32x4){0, 0, 0, 0};
                    const u32x4 y2 = (s < seq - 1) ? *(const u32x4*)(yp + ld) : (u32x4){0, 0, 0, 0};
                    const f32x4 b0 = acc[ai][bj][m][0], b1 = acc[ai][bj][m][1];
                    float r[8];
#pragma unroll
                    for (int e = 0; e < 4; ++e) {
                        const float l0 = __uint_as_float(y0[e] << 16), h0 = __uint_as_float(y0[e] & 0xffff0000u);
                        const float l1 = __uint_as_float(y1[e] << 16), h1 = __uint_as_float(y1[e] & 0xffff0000u);
                        const float l2 = __uint_as_float(y2[e] << 16), h2 = __uint_as_float(y2[e] & 0xffff0000u);
                        const float wl0 = (e < 2) ? w0a[2 * e] : w0b[2 * e - 4], wh0 = (e < 2) ? w0a[2 * e + 1] : w0b[2 * e - 3];
                        const float wl1 = (e < 2) ? w1a[2 * e] : w1b[2 * e - 4], wh1 = (e < 2) ? w1a[2 * e + 1] : w1b[2 * e - 3];
                        const float wl2 = (e < 2) ? w2a[2 * e] : w2b[2 * e - 4], wh2 = (e < 2) ? w2a[2 * e + 1] : w2b[2 * e - 3];
                        const float bl = (e < 2) ? b0[2 * e] : b1[2 * e - 4], bh = (e < 2) ? b0[2 * e + 1] : b1[2 * e - 3];
                        r[2 * e] = bl * (wl0 * l0 + wl1 * l1 + wl2 * l2);
                        r[2 * e + 1] = bh * (wh0 * h0 + wh1 * h1 + wh2 * h2);
                    }
                    u32x4 w; w.x = cvt_pk_bf16(r[0], r[1]); w.y = cvt_pk_bf16(r[2], r[3]); w.z = cvt_pk_bf16(r[4], r[5]); w.w = cvt_pk_bf16(r[6], r[7]);
                    *(u32x4*)(Z + (size_t)row * ld + col) = w;
                }
        }
    }
};
struct EpiInProj {
    static constexpr bool PERM = true, AFTER_DRAIN = false;
    bf16_t* O; int ldc; const float* rope; int seq;
    __device__ __forceinline__ void operator()(const f32x4 (&acc)[2][2][4][2], const Unit& u, int wr, int wc, int fr, int fq) const {
        const int row0 = u.pm * BM + wr * 64 + fr; const int col0 = u.pn * BM + wc * 32 + 8 * fq;
        const int axis = wc & 1; const float sgn = (fq & 2) ? 1.0f : -1.0f; const int i0 = 8 * (fq & 1);
#pragma unroll
        for (int ai = 0; ai < 2; ++ai)
#pragma unroll
            for (int m = 0; m < 4; ++m) { const int row = row0 + ai * HALF + m * 16; bf16_t* rowp = O + (size_t)row * ldc + col0;
                const int s = row % seq; const int pos = axis ? (s & 63) : (s >> 6);
                const f32x4* rp = (const f32x4*)(rope + ((size_t)pos * 16 + i0) * 2);
#pragma unroll
                for (int bj = 0; bj < 2; ++bj) { f32x4 v0 = acc[ai][bj][m][0], v1 = acc[ai][bj][m][1];
                    const bool do_rope = (u.pn < 2) || (u.pn == 2 && bj == 0);
                    if (do_rope) {
                        const f32x4 cs0 = rp[0], cs1 = rp[1], cs2 = rp[2], cs3 = rp[3];
                        f32x4 p0, p1;
#pragma unroll
                        for (int j = 0; j < 4; ++j) { p0[j] = __shfl_xor(v0[j], 32); p1[j] = __shfl_xor(v1[j], 32); }
                        const float sc = (u.pn < 2) ? 0.125f * 1.4426950408889634f : 1.0f;
                        v0[0] = (v0[0] * cs0[0] + sgn * p0[0] * cs0[1]) * sc; v0[1] = (v0[1] * cs0[2] + sgn * p0[1] * cs0[3]) * sc;
                        v0[2] = (v0[2] * cs1[0] + sgn * p0[2] * cs1[1]) * sc; v0[3] = (v0[3] * cs1[2] + sgn * p0[3] * cs1[3]) * sc;
                        v1[0] = (v1[0] * cs2[0] + sgn * p1[0] * cs2[1]) * sc; v1[1] = (v1[1] * cs2[2] + sgn * p1[1] * cs2[3]) * sc;
                        v1[2] = (v1[2] * cs3[0] + sgn * p1[2] * cs3[1]) * sc; v1[3] = (v1[3] * cs3[2] + sgn * p1[3] * cs3[3]) * sc;
                    }
                    u32x4 w; w.x = cvt_pk_bf16(v0[0], v0[1]); w.y = cvt_pk_bf16(v0[2], v0[3]); w.z = cvt_pk_bf16(v1[0], v1[1]); w.w = cvt_pk_bf16(v1[2], v1[3]);
                    *(u32x4*)(rowp + bj * HALF) = w; } }
    }
};

template <class Epi, class Sched, bool ALIGN_EPI = false, bool SP2 = false>
__device__ __forceinline__ void gemm_phase(PG8_LAS unsigned char* lds, const Gemm g, const Sched& S, const Epi& E) {
    const int tid = threadIdx.x, wid = __builtin_amdgcn_readfirstlane(tid >> 6), lane = tid & 63, wr = wid >> 2, wc = wid & 3, fr = lane & 15, fq = lane >> 4;
    const int K = g.K, nt = K / BK;
    unsigned voffA[2], voffB[2];
#pragma unroll
    for (int i = 0; i < 2; ++i) { int R, C; stage_rc(tid * 16 + i * 8192, R, C); const int Rb = Epi::PERM ? ((R & ~31) + perm32(R & 31)) : R;
        voffA[i] = (unsigned)(R * K + C) * 2u; voffB[i] = (unsigned)(Rb * K + C) * 2u; }
    const size_t kstep = (size_t)(BK * 2);
    const size_t hstep = (size_t)HALF * K * 2;
    const size_t tstep = 2 * hstep;
    const unsigned ldsw = (unsigned)wid * 1024u;
    const int aoff = lds_byte(wr * 64 + fr, fq * 8), boff = lds_byte(wc * 32 + fr, fq * 8);
#define PG8_SA(b, h) (((b) * 2 + (h)) * HTB)
#define PG8_SB(b, h) ((4 + (b) * 2 + (h)) * HTB)
#define PG8_STAGE(bufoff, gbase, voff) do { _Pragma("unroll") for (int _i = 0; _i < 2; ++_i) \
        __builtin_amdgcn_global_load_lds((const unsigned*)((const char*)(gbase) + (voff)[_i]), (PG8_LAS unsigned*)(lds + (bufoff) + ldsw + _i * 8192), 16, 0, 0); } while (0)
#define PG8_LDA(dst, b, h) do { _Pragma("unroll") for (int m = 0; m < 4; ++m) _Pragma("unroll") for (int k = 0; k < 2; ++k) dst[m][k] = *(const PG8_LAS bf16x8*)(lds + PG8_SA(b, h) + aoff + m * 2048 + k * 1024); } while (0)
#define PG8_LDB(dst, b, h) do { _Pragma("unroll") for (int n = 0; n < 2; ++n) _Pragma("unroll") for (int k = 0; k < 2; ++k) dst[n][k] = *(const PG8_LAS bf16x8*)(lds + PG8_SB(b, h) + boff + n * 2048 + k * 1024); } while (0)
#define PG8_MMA(ai, bj, At, Bt) do { __builtin_amdgcn_s_setprio(1); _Pragma("unroll") for (int m = 0; m < 4; ++m) _Pragma("unroll") for (int n = 0; n < 2; ++n) _Pragma("unroll") for (int k = 0; k < 2; ++k) \
        acc[ai][bj][m][n] = __builtin_amdgcn_mfma_f32_16x16x32_bf16(Bt[n][k], At[m][k], acc[ai][bj][m][n], 0, 0, 0); __builtin_amdgcn_s_setprio(0); } while (0)
#define PG8_WAIT_V(n) asm volatile("s_waitcnt vmcnt(" #n ")" ::: "memory")
#define PG8_WAIT_L(n) asm volatile("s_waitcnt lgkmcnt(" #n ")" ::: "memory")
#define PG8_BAR __builtin_amdgcn_s_barrier()
#define PG8_SCHED __builtin_amdgcn_sched_barrier(0)
    Unit cur, nxt; int ui = 0;
    if (!S.next(0, cur)) return;
    f32x4 acc[2][2][4][2];
#pragma unroll
    for (int a = 0; a < 2; ++a)
#pragma unroll
        for (int b = 0; b < 2; ++b)
#pragma unroll
            for (int m = 0; m < 4; ++m)
#pragma unroll
                for (int n = 0; n < 2; ++n) acc[a][b][m][n] = (f32x4){0.f, 0.f, 0.f, 0.f};
    bf16x8 At[4][2], B0[2][2], B1[2][2];
    const char* cA = (const char*)g.A + (size_t)cur.pm * tstep; const char* cB = (const char*)g.Bt + (size_t)cur.pn * tstep;
    S.a_ready(cur);
    if constexpr (SP2) {
        PG8_STAGE(PG8_SB(0, 0), cB, voffB); PG8_STAGE(PG8_SB(0, 1), cB + hstep, voffB); PG8_STAGE(PG8_SA(0, 0), cA, voffA); PG8_STAGE(PG8_SA(0, 1), cA + hstep, voffA);
        if (wr == 1) PG8_BAR;
        PG8_WAIT_V(2); PG8_BAR;
        PG8_STAGE(PG8_SB(1, 0), cB + kstep, voffB); PG8_STAGE(PG8_SA(1, 0), cA + kstep, voffA); PG8_STAGE(PG8_SB(1, 1), cB + hstep + kstep, voffB);
        PG8_WAIT_V(6); PG8_BAR;
    } else {
        PG8_STAGE(PG8_SB(0, 0), cB, voffB); PG8_STAGE(PG8_SA(0, 0), cA, voffA); PG8_STAGE(PG8_SB(0, 1), cB + hstep, voffB); PG8_STAGE(PG8_SA(0, 1), cA + hstep, voffA);
        if (wr == 1) PG8_BAR;
        PG8_WAIT_V(4); PG8_BAR;
        PG8_STAGE(PG8_SB(1, 0), cB + kstep, voffB); PG8_STAGE(PG8_SA(1, 0), cA + kstep, voffA); PG8_STAGE(PG8_SB(1, 1), cB + hstep + kstep, voffB);
        PG8_WAIT_V(6); PG8_BAR;
    }
    for (;;) {
        const bool has_next = S.next(ui + 1, nxt);
        const char* nA = has_next ? (const char*)g.A + (size_t)nxt.pm * tstep : cA; const char* nB = has_next ? (const char*)g.Bt + (size_t)nxt.pn * tstep : cB;
        for (int t = 0; t < nt; t += 2) {
            const bool last = (t == nt - 2);
            const char* a1 = cA + (size_t)(t + 1) * kstep;
            const char* a2 = last ? nA : cA + (size_t)(t + 2) * kstep; const char* b2 = last ? nB : cB + (size_t)(t + 2) * kstep;
            const char* a3 = a2 + kstep; const char* b3 = b2 + kstep;
            if (last && has_next) S.a_ready(nxt);
            if constexpr (SP2) {
            PG8_LDB(B0, 0, 0); PG8_LDB(B1, 0, 1); PG8_SCHED; PG8_LDA(At, 0, 0); PG8_STAGE(PG8_SA(1, 1), a1 + hstep, voffA);
            PG8_WAIT_V(8); PG8_WAIT_L(0); PG8_BAR; PG8_MMA(0, 0, At, B0); PG8_MMA(0, 1, At, B1); PG8_BAR; PG8_SCHED;
            PG8_LDA(At, 0, 1); PG8_STAGE(PG8_SB(0, 0), b2, voffB); PG8_STAGE(PG8_SB(0, 1), b2 + hstep, voffB); PG8_STAGE(PG8_SA(0, 0), a2, voffA);
            PG8_WAIT_V(8); PG8_WAIT_L(0); PG8_BAR; PG8_MMA(1, 0, At, B0); PG8_MMA(1, 1, At, B1); PG8_BAR; PG8_SCHED;
            PG8_LDB(B0, 1, 0); PG8_LDB(B1, 1, 1); PG8_SCHED; PG8_LDA(At, 1, 0); PG8_STAGE(PG8_SA(0, 1), a2 + hstep, voffA);
            PG8_WAIT_V(8); PG8_WAIT_L(0); PG8_BAR; PG8_MMA(0, 0, At, B0); PG8_MMA(0, 1, At, B1); PG8_BAR; PG8_SCHED;
            PG8_LDA(At, 1, 1); PG8_STAGE(PG8_SB(1, 0), b3, voffB); PG8_STAGE(PG8_SB(1, 1), b3 + hstep, voffB); PG8_STAGE(PG8_SA(1, 0), a3, voffA);
            PG8_WAIT_V(8); PG8_WAIT_L(0); PG8_BAR; PG8_MMA(1, 0, At, B0); PG8_MMA(1, 1, At, B1); PG8_BAR; PG8_SCHED;
            } else {
            PG8_LDB(B0, 0, 0); PG8_SCHED; PG8_LDA(At, 0, 0); PG8_STAGE(PG8_SA(1, 1), a1 + hstep, voffA);
            PG8_WAIT_L(8); PG8_BAR; PG8_WAIT_L(0); PG8_MMA(0, 0, At, B0); PG8_BAR; PG8_SCHED;
            PG8_LDB(B1, 0, 1); PG8_STAGE(PG8_SB(0, 0), b2, voffB);
            PG8_BAR; PG8_WAIT_L(0); PG8_MMA(0, 1, At, B1); PG8_BAR;
            PG8_LDA(At, 0, 1); PG8_STAGE(PG8_SA(0, 0), a2, voffA);
            PG8_BAR; PG8_WAIT_L(0); PG8_MMA(1, 0, At, B0); PG8_BAR; PG8_SCHED;
            PG8_STAGE(PG8_SB(0, 1), b2 + hstep, voffB);
            PG8_WAIT_V(6); PG8_BAR; PG8_MMA(1, 1, At, B1); PG8_BAR;
            PG8_LDB(B0, 1, 0); PG8_SCHED; PG8_LDA(At, 1, 0); PG8_STAGE(PG8_SA(0, 1), a2 + hstep, voffA);
            PG8_WAIT_L(8); PG8_BAR; PG8_WAIT_L(0); PG8_MMA(0, 0, At, B0); PG8_BAR; PG8_SCHED;
            PG8_LDB(B1, 1, 1); PG8_STAGE(PG8_SB(1, 0), b3, voffB);
            PG8_BAR; PG8_WAIT_L(0); PG8_MMA(0, 1, At, B1); PG8_BAR;
            PG8_LDA(At, 1, 1); PG8_STAGE(PG8_SA(1, 0), a3, voffA);
            PG8_BAR; PG8_WAIT_L(0); PG8_MMA(1, 0, At, B0); PG8_BAR; PG8_SCHED;
            PG8_STAGE(PG8_SB(1, 1), b3 + hstep, voffB);
            PG8_WAIT_V(6); PG8_BAR; PG8_MMA(1, 1, At, B1); PG8_BAR;
            }
        }
        if constexpr (ALIGN_EPI) { if (wr == 0) PG8_BAR; }
        if constexpr (!Epi::AFTER_DRAIN) { E(acc, cur, wr, wc, fr, fq); S.done(cur); }
        if (!has_next) break;
#pragma unroll
        for (int a = 0; a < 2; ++a)
#pragma unroll
            for (int b = 0; b < 2; ++b)
#pragma unroll
                for (int m = 0; m < 4; ++m)
#pragma unroll
                    for (int n = 0; n < 2; ++n) acc[a][b][m][n] = (f32x4){0.f, 0.f, 0.f, 0.f};
        cur = nxt; cA = nA; cB = nB; ++ui;
        if constexpr (ALIGN_EPI) { if (wr == 1) PG8_BAR; }
    }
    PG8_WAIT_V(0);
    if constexpr (!ALIGN_EPI) { if (wr == 0) PG8_BAR; }
    PG8_BAR;
    if constexpr (Epi::AFTER_DRAIN) { E.fused(acc, cur, wr, wc, fr, fq, lds, wid, lane); S.done(cur); }
#undef PG8_SA
#undef PG8_SB
#undef PG8_STAGE
#undef PG8_LDA
#undef PG8_LDB
#undef PG8_MMA
#undef PG8_WAIT_V
#undef PG8_WAIT_L
#undef PG8_BAR
#undef PG8_SCHED
}
}

constexpr int NB = 2, SEQ = 16384, T = NB * SEQ, D = 1024, CTXL = 256, TC = NB * CTXL, DFF = 2816;
constexpr int NIN0 = 1792, NIN1 = 3072, HD = 64;
constexpr int NWAVES = 8, NTHR = NWAVES * 64;
constexpr float RMS_EPS = 1e-6f, LN_EPS = 1e-5f, LOG2E = 1.4426950408889634f;

constexpr size_t MiB = 1u << 20;
constexpr size_t WS_CTL = 0, CTL_ZERO_BYTES = 65536;
constexpr size_t WS_MOD = 1 * MiB;
constexpr size_t WS_MODC = WS_MOD + 128 * 1024;
constexpr size_t WS_ROPE = WS_MOD + 192 * 1024;
constexpr size_t WS_WIN = 2 * MiB, WS_WOUT = 6 * MiB, WS_W13 = 8 * MiB  , WS_W2 = 30 * MiB  , WS_SCIN = 42 * MiB, WS_SCOUT = 48 * MiB;
constexpr size_t WS_KVC = 50 * MiB;
constexpr size_t WS_WSB = 51 * MiB;
constexpr size_t WS_H = 52 * MiB;
constexpr size_t WS_BIG = 120 * MiB;
constexpr size_t WS_O = 296 * MiB;
constexpr size_t WS_Y = 360 * MiB;
constexpr size_t WS_XB = 424 * MiB;
constexpr size_t WS_END = 488 * MiB;
constexpr int LDS_BYTES = 147456;

#define LAS __attribute__((address_space(3)))
typedef unsigned short bf16;
typedef float f32x4 __attribute__((ext_vector_type(4)));
typedef float f32x16 __attribute__((ext_vector_type(16)));
typedef short bf16x8 __attribute__((ext_vector_type(8)));
typedef short s16x4 __attribute__((ext_vector_type(4)));
typedef unsigned u32x4 __attribute__((ext_vector_type(4)));
typedef unsigned u32x2 __attribute__((ext_vector_type(2)));
using pg8::cvt_pk_bf16;
__device__ __forceinline__ float bf2f(unsigned short v) { return __uint_as_float((unsigned)v << 16); }
__device__ __forceinline__ float bflo(unsigned v) { return __uint_as_float(v << 16); }
__device__ __forceinline__ float bfhi(unsigned v) { return __uint_as_float(v & 0xffff0000u); }
__device__ __forceinline__ float wave_sum(float v) {
#pragma unroll
    for (int o = 1; o < 64; o <<= 1) v += __shfl_xor(v, o);
    return v;
}
typedef short v4i16_t __attribute__((ext_vector_type(4)));
__device__ __forceinline__ s16x4 vtr(const LAS char* p) { return __builtin_bit_cast(s16x4, __builtin_amdgcn_ds_read_tr16_b64_v4i16((LAS v4i16_t*)p)); }
__device__ __forceinline__ int crow(int r, int hi) { return (r & 3) + 8 * (r >> 2) + 4 * hi; }

struct Args {
    const float *x, *c, *ctx, *c_ctx, *w_mod, *b_mod, *g_mix_pre, *g_mix_post, *g_ffn_pre, *g_ffn_post, *ffn_w1, *ffn_w3, *ffn_w2, *a_w_in, *a_sink, *gm_v_norm, *gm_ws, *gm_bs, *a_w_out, *sc_w_in, *sc_conv, *sc_w_out;
    float* out; unsigned char* ws; int ph_lo, ph_hi;
};


#define XB_TMO      128
#define XB_XCNT(j)  (256  + 64 * (j))
#define XB_XSUB(j)  (1280 + 64 * (j))
#define XB_XGEN(j)  (2304 + 64 * (j))
#define XB_TOP      3328
#define XB_TOPGEN   3392
#define XCD_BAR_WORDS 3456
#define XB_SPIN_CAP (1u << 18)

__device__ __forceinline__ unsigned xb_ld(unsigned* p)              { return __hip_atomic_load(p, __ATOMIC_RELAXED, __HIP_MEMORY_SCOPE_AGENT); }
__device__ __forceinline__ unsigned xb_add(unsigned* p, unsigned v) { return __hip_atomic_fetch_add(p, v, __ATOMIC_RELAXED, __HIP_MEMORY_SCOPE_AGENT); }
__device__ __forceinline__ unsigned xb_xcc_id() { return (unsigned)__builtin_amdgcn_s_getreg((3 << 11) | 20) & 0xFu; }
#define XB_SPIN(cond, bar) do { unsigned _sp = 0; while (cond) { __builtin_amdgcn_s_sleep(1); \
    if ((++_sp & 255u) == 0u) { if (xb_ld(&(bar)[XB_TMO])) break; if (_sp > XB_SPIN_CAP) { atomicAdd(&(bar)[XB_TMO], 1u); break; } } } } while (0)

struct XcdBarrier {
    unsigned* bar; unsigned x;
    volatile LAS unsigned* st;
};

__device__ __forceinline__ XcdBarrier xcd_barrier_post(unsigned* bar, volatile LAS unsigned* st) {
    XcdBarrier b; b.bar = bar; b.x = xb_xcc_id(); b.st = st;
    if (threadIdx.x == 0) st[2] = xb_add(&bar[XB_XCNT(b.x)], 1u);
    return b;
}
__device__ __forceinline__ void xcd_barrier_complete(unsigned* bar, unsigned x, unsigned& nloc, unsigned& nx) {
    const unsigned G = gridDim.x * gridDim.y * gridDim.z;
    unsigned sum, cnt, mine, sp = 0u;
    for (;;) {
        sum = 0u; cnt = 0u; mine = 0u;
#pragma unroll
        for (unsigned j = 0; j < 16; ++j) { const unsigned c = xb_ld(&bar[XB_XCNT(j)]); sum += c; cnt += (c > 0u) ? 1u : 0u; mine = (j == x) ? c : mine; }
        if (sum == G) break;
        __builtin_amdgcn_s_sleep(1);
        if ((++sp & 255u) == 0u) { if (xb_ld(&bar[XB_TMO])) break; if (sp > XB_SPIN_CAP) { atomicAdd(&bar[XB_TMO], 1u); break; } }
    }
    nloc = mine > 0u ? mine : 1u; nx = cnt > 0u ? cnt : 1u;
}

__device__ __forceinline__ void xcd_barrier(const XcdBarrier& b) {
    asm volatile("s_waitcnt vmcnt(0)" ::: "memory");
    __syncthreads();
    if (threadIdx.x == 0) {
        unsigned* bar = b.bar;
        __builtin_amdgcn_s_waitcnt(0);
        unsigned nloc = b.st[0], nx = b.st[1];
        if (nloc == 0u) { xcd_barrier_complete(bar, b.x, nloc, nx); b.st[0] = nloc; b.st[1] = nx; }
        const unsigned old = xb_add(&bar[XB_XSUB(b.x)], 1u);
        const unsigned gen = old / nloc;
        if (old + 1u == (gen + 1u) * nloc) {
            __builtin_amdgcn_fence(__ATOMIC_RELEASE, "agent");
            asm volatile("s_waitcnt vmcnt(0)" ::: "memory");
            const unsigned og = xb_add(&bar[XB_TOP], 1u);
            const unsigned tg = og / nx;
            if (og + 1u == (tg + 1u) * nx) xb_add(&bar[XB_TOPGEN], 1u);
            else XB_SPIN(xb_ld(&bar[XB_TOPGEN]) == tg, bar);
            __builtin_amdgcn_fence(__ATOMIC_ACQUIRE, "agent");
            xb_add(&bar[XB_XGEN(b.x)], 1u);
            asm volatile("s_waitcnt vmcnt(0)" ::: "memory");
        } else {
            XB_SPIN(xb_ld(&bar[XB_XGEN(b.x)]) == gen, bar);
            __builtin_amdgcn_fence(__ATOMIC_ACQUIRE, "agent");
            asm volatile("s_waitcnt vmcnt(0)" ::: "memory");
        }
    }
    __syncthreads();
}

#define XH_TOP(h)     (5504 + 128 * (h))
#define XH_TOPGEN(h)  (5568 + 128 * (h))
#define XW_FLAG       5760
__device__ __forceinline__ void xcd_half_barrier(const XcdBarrier& b, unsigned h) {
    asm volatile("s_waitcnt vmcnt(0)" ::: "memory");
    __syncthreads();
    if (threadIdx.x == 0) {
        unsigned* bar = b.bar;
        __builtin_amdgcn_s_waitcnt(0);
        const unsigned nloc = b.st[0], nx = 4u;
        const unsigned old = xb_add(&bar[XB_XSUB(b.x)], 1u);
        const unsigned gen = old / nloc;
        if (old + 1u == (gen + 1u) * nloc) {
            __builtin_amdgcn_fence(__ATOMIC_RELEASE, "agent");
            asm volatile("s_waitcnt vmcnt(0)" ::: "memory");
            const unsigned og = xb_add(&bar[XH_TOP(h)], 1u);
            const unsigned tg = og / nx;
            if (og + 1u == (tg + 1u) * nx) xb_add(&bar[XH_TOPGEN(h)], 1u);
            else XB_SPIN(xb_ld(&bar[XH_TOPGEN(h)]) == tg, bar);
            __builtin_amdgcn_fence(__ATOMIC_ACQUIRE, "agent");
            xb_add(&bar[XB_XGEN(b.x)], 1u);
            asm volatile("s_waitcnt vmcnt(0)" ::: "memory");
        } else {
            XB_SPIN(xb_ld(&bar[XB_XGEN(b.x)]) == gen, bar);
            __builtin_amdgcn_fence(__ATOMIC_ACQUIRE, "agent");
            asm volatile("s_waitcnt vmcnt(0)" ::: "memory");
        }
    }
    __syncthreads();
}

#define XL_SUB(j)  (3456 + 64 * (j))
#define XL_GEN(j)  (4480 + 64 * (j))
#define XL_WORDS   5888
__device__ __forceinline__ void xcd_local_barrier(const XcdBarrier& b) {
    asm volatile("s_waitcnt vmcnt(0)" ::: "memory");
    __syncthreads();
    if (threadIdx.x == 0) {
        unsigned* bar = b.bar;
        __builtin_amdgcn_s_waitcnt(0);
        const unsigned nloc = b.st[0];
        const unsigned old = xb_add(&bar[XL_SUB(b.x)], 1u);
        const unsigned gen = old / nloc;
        if (old + 1u == (gen + 1u) * nloc) xb_add(&bar[XL_GEN(b.x)], 1u);
        else XB_SPIN(xb_ld(&bar[XL_GEN(b.x)]) == gen, bar);
        __builtin_amdgcn_fence(__ATOMIC_ACQUIRE, "agent");
        asm volatile("s_waitcnt vmcnt(0)" ::: "memory");
    }
    __syncthreads();
}

__device__ __forceinline__ void p0_transpose_item(const float* W, int K, int N, bf16* WT, int mode, LAS float* scr, int item, int lane) {
    const int nblk = N / 32, kb = item / nblk, nb = item % nblk, k0 = 64 * kb, n0 = 32 * nb;
    int drow0 = n0;
    if (mode == 1) drow0 = (n0 >> 7) * 256 + (n0 & 127);
    else if (mode == 2) drow0 = (n0 >> 7) * 256 + 128 + (n0 & 127);
    else if (mode == 3) {
        if (n0 < 1024) drow0 = 2048 + n0;
        else if (n0 < 2048) { const int j = n0 - 1024; drow0 = (j >> 7) * 256 + (j & 127); }
        else { const int j = n0 - 2048; drow0 = (j >> 7) * 256 + 128 + (j & 127); }
    }
#pragma unroll 8
    for (int i = 0; i < 32; ++i) { const int kk = 2 * i + (lane >> 5); scr[kk * 33 + (lane & 31)] = __builtin_nontemporal_load(W + (size_t)(k0 + kk) * N + n0 + (lane & 31)); }
    asm volatile("s_waitcnt lgkmcnt(0)" ::: "memory");
    const int c = lane & 7;
#pragma unroll
    for (int j = 0; j < 4; ++j) { const int n = (lane >> 3) + 8 * j; const LAS float* s = scr + (8 * c) * 33 + n;
        u32x4 o; o.x = cvt_pk_bf16(s[0 * 33], s[1 * 33]); o.y = cvt_pk_bf16(s[2 * 33], s[3 * 33]); o.z = cvt_pk_bf16(s[4 * 33], s[5 * 33]); o.w = cvt_pk_bf16(s[6 * 33], s[7 * 33]);
        *(u32x4*)(WT + (size_t)(drow0 + n) * K + k0 + 8 * c) = o; }
    asm volatile("s_waitcnt lgkmcnt(0)" ::: "memory");
}


constexpr int I_IN = 16 * 56, I_OUT = 16 * 32, I_W1 = 16 * 88, I_W2 = 44 * 32, I_SCI = 16 * 96, I_SCO = 16 * 32;
constexpr int NT_ITEMS = I_IN + I_OUT + 4 * I_W1 + 2 * I_W2 + I_SCI + I_SCO, NP0_ITEMS = I_IN + I_OUT;
__device__ __forceinline__ void transpose_dispatch(const Args& a, int it, LAS float* scr, int lane) {
    unsigned char* ws = a.ws; int r = it;
    if (r < I_IN) { p0_transpose_item(a.a_w_in, 1024, NIN0, (bf16*)(ws + WS_WIN), 0, scr, r, lane); return; } r -= I_IN;
    if (r < I_OUT) { p0_transpose_item(a.a_w_out, 1024, 1024, (bf16*)(ws + WS_WOUT), 0, scr, r, lane); return; } r -= I_OUT;
    if (r < 4 * I_W1) { const int q = r / I_W1, layer = q >> 1, which = q & 1; r -= q * I_W1;
        p0_transpose_item((which ? a.ffn_w3 : a.ffn_w1) + (size_t)layer * 1024 * DFF, 1024, DFF, (bf16*)(ws + WS_W13 + layer * 11 * MiB), 1 + which, scr, r, lane); return; } r -= 4 * I_W1;
    if (r < 2 * I_W2) { const int layer = r / I_W2; r -= layer * I_W2;
        p0_transpose_item(a.ffn_w2 + (size_t)layer * DFF * 1024, DFF, 1024, (bf16*)(ws + WS_W2 + layer * 6 * MiB), 0, scr, r, lane); return; } r -= 2 * I_W2;
    if (r < I_SCI) { p0_transpose_item(a.sc_w_in, 1024, NIN1, (bf16*)(ws + WS_SCIN), 3, scr, r, lane); return; } r -= I_SCI;
    p0_transpose_item(a.sc_w_out, 1024, 1024, (bf16*)(ws + WS_SCOUT), 0, scr, r, lane);
}

__device__ __forceinline__ float silu_f(float v) { return v / (1.0f + __expf(-v)); }

__device__ __forceinline__ void p0_prologue(const Args& a, LAS unsigned char* lds, int G) {
    const int tid = threadIdx.x, lane = tid & 63, wid = __builtin_amdgcn_readfirstlane(tid >> 6);
    unsigned char* ws = a.ws;
    float* mod = (float*)(ws + WS_MOD); float* modc = (float*)(ws + WS_MODC); float* rope = (float*)(ws + WS_ROPE);
    for (int e = blockIdx.x * NTHR + tid; e < 256 * 16; e += G * NTHR) {
        const int pos = e >> 4, i = e & 15;
        const float inv = exp2f(-(float)i * (13.287712379549449f / 16.0f));
        const float ang = (float)pos * inv;
        const double rev = (double)ang * 0.15915494309189533577;
        const float fr = (float)(rev - floor(rev));
        rope[2 * e] = __builtin_amdgcn_cosf(fr); rope[2 * e + 1] = __builtin_amdgcn_sinf(fr);
    }
    for (int e = blockIdx.x * NTHR + tid; e < 8 * 128 * 128 / 8; e += G * NTHR) {
        const f32x4 v0 = *(const f32x4*)(a.gm_ws + (size_t)e * 8), v1 = *(const f32x4*)(a.gm_ws + (size_t)e * 8 + 4);
        u32x4 w; w.x = cvt_pk_bf16(v0[0], v0[1]); w.y = cvt_pk_bf16(v0[2], v0[3]); w.z = cvt_pk_bf16(v1[0], v1[1]); w.w = cvt_pk_bf16(v1[2], v1[3]);
        *(u32x4*)((bf16*)(ws + WS_WSB) + (size_t)e * 8) = w;
    }
    LAS float* sv = (LAS float*)lds;
    LAS float* red = (LAS float*)(lds + 12288);
    bool have_silu = false;
    for (int it = blockIdx.x; it < 48; it += G) {
        if (!have_silu) {
            for (int k = tid; k < 1024; k += NTHR) { sv[k] = silu_f(a.c[k]); sv[1024 + k] = silu_f(a.c[1024 + k]); sv[2048 + k] = silu_f(a.c_ctx[k]); }
            have_silu = true;
        }
        __syncthreads();
        const int layer = it / 24, cgp = it % 24, c0 = cgp * 256;
        const float* W = a.w_mod + (size_t)layer * 1024 * 6144 + c0 + 4 * lane;
        f32x4 a0 = {0, 0, 0, 0}, a1 = {0, 0, 0, 0}, a2 = {0, 0, 0, 0};
        const int kb = wid * 128;
#pragma unroll 8
        for (int k = 0; k < 128; ++k) {
            const f32x4 w = __builtin_nontemporal_load((const f32x4*)(W + (size_t)(kb + k) * 6144));
            const float s0 = sv[kb + k], s1 = sv[1024 + kb + k], s2 = sv[2048 + kb + k];
            a0 += w * s0; a1 += w * s1; a2 += w * s2;
        }
        *(LAS f32x4*)(red + (wid * 3 + 0) * 256 + 4 * lane) = a0;
        *(LAS f32x4*)(red + (wid * 3 + 1) * 256 + 4 * lane) = a1;
        *(LAS f32x4*)(red + (wid * 3 + 2) * 256 + 4 * lane) = a2;
        __syncthreads();
        if (tid < 256) {
            float r0 = 0.f, r1 = 0.f, r2 = 0.f;
#pragma unroll
            for (int w = 0; w < 8; ++w) { r0 += red[(w * 3 + 0) * 256 + tid]; r1 += red[(w * 3 + 1) * 256 + tid]; r2 += red[(w * 3 + 2) * 256 + tid]; }
            const float bias = a.b_mod[layer * 6144 + c0 + tid];
            mod[(layer * 2 + 0) * 6144 + c0 + tid] = r0 + bias;
            mod[(layer * 2 + 1) * 6144 + c0 + tid] = r1 + bias;
            if (layer == 0 && c0 < 2048) modc[c0 + tid] = r2 + bias;
        }
    }
    __syncthreads();
    LAS float* scr = (LAS float*)(lds + wid * 16384);
    const int gw = blockIdx.x * NWAVES + wid, NGW = G * NWAVES;
    for (int it = gw; it < NP0_ITEMS; it += NGW) transpose_dispatch(a, it, scr, lane);
}
__device__ __forceinline__ void late_transposes(const Args& a, LAS unsigned char* lds, int worker, int nworkers) {
    const int lane = threadIdx.x & 63, wid = __builtin_amdgcn_readfirstlane(threadIdx.x >> 6);
    LAS float* scr = (LAS float*)(lds + wid * 16384);
    for (int it = NP0_ITEMS + worker; it < NT_ITEMS; it += nworkers) transpose_dispatch(a, it, scr, lane);
}

template <bool XIN16, bool XOUT16>
__device__ __forceinline__ void rowpass(const void* xin_, const bf16* Y, void* xout_, bf16* H, const float* gpost, const float* gate, const float* gpre, const float* sc, const float* sh,
                                        int mod_stride, int nrows, int rows_per_batch, int G, int blk) {
    const int tid = threadIdx.x, lane = tid & 63, wid = __builtin_amdgcn_readfirstlane(tid >> 6);
    const int NGW = G * NWAVES;
    const int vb = (G % 8 == 0) ? (blk % 8) * (G / 8) + (blk / 8) : blk;
    const int gw = vb * NWAVES + wid;
    const int rpw = (nrows + NGW - 1) / NGW;
    const int r0 = gw * rpw, r1 = (r0 + rpw < nrows) ? r0 + rpw : nrows;
    f32x4 A1[4], A2[4], A3[4];
    int curb = -1;
    const bool go = (G == 256) && (nrows == T) && (rpw == 16);
    for (int idx = 0; idx < r1 - r0; ++idx) {
        const int r = go ? ((vb >> 5) * 4096 + ((idx < 8) ? 2048 : 0) + ((vb & 31) * NWAVES + wid) * 8 + (idx & 7)) : (r0 + idx);
        const int b = r / rows_per_batch;
        if (b != curb) { curb = b;
#pragma unroll
            for (int j = 0; j < 4; ++j) { const int cidx = 4 * lane + 256 * j;
                if (Y) { A1[j] = *(const f32x4*)(gate + (size_t)b * mod_stride + cidx) * *(const f32x4*)(gpost + cidx); }
                if (H) { A2[j] = *(const f32x4*)(gpre + cidx) * (*(const f32x4*)(sc + (size_t)b * mod_stride + cidx) + 1.0f); A3[j] = *(const f32x4*)(sh + (size_t)b * mod_stride + cidx); }
            }
        }
        f32x4 xv[4];
        if (XIN16) {
#pragma unroll
            for (int j = 0; j < 4; ++j) { const u32x2 w = __builtin_nontemporal_load((const u32x2*)((const bf16*)xin_ + (size_t)r * D + 4 * lane + 256 * j)); xv[j] = (f32x4){bflo(w.x), bfhi(w.x), bflo(w.y), bfhi(w.y)}; }
        } else {
#pragma unroll
            for (int j = 0; j < 4; ++j) xv[j] = __builtin_nontemporal_load((const f32x4*)((const float*)xin_ + (size_t)r * D + 4 * lane + 256 * j));
        }
        if (Y) {
            f32x4 yv[4]; float s = 0.f;
#pragma unroll
            for (int j = 0; j < 4; ++j) { const u32x2 w = __builtin_nontemporal_load((const u32x2*)(Y + (size_t)r * D + 4 * lane + 256 * j));
                yv[j] = (f32x4){bflo(w.x), bfhi(w.x), bflo(w.y), bfhi(w.y)}; s += (yv[j][0] * yv[j][0] + yv[j][1] * yv[j][1]) + (yv[j][2] * yv[j][2] + yv[j][3] * yv[j][3]); }
            const float ry = 1.0f / sqrtf(wave_sum(s) * (1.0f / D) + RMS_EPS);
#pragma unroll
            for (int j = 0; j < 4; ++j) xv[j] = xv[j] + A1[j] * (yv[j] * ry);
        }
        if (xout_) {
            if (XOUT16) {
#pragma unroll
                for (int j = 0; j < 4; ++j) { u32x2 w; w.x = cvt_pk_bf16(xv[j][0], xv[j][1]); w.y = cvt_pk_bf16(xv[j][2], xv[j][3]); __builtin_nontemporal_store(w, (u32x2*)((bf16*)xout_ + (size_t)r * D + 4 * lane + 256 * j)); }
            } else {
#pragma unroll
                for (int j = 0; j < 4; ++j) __builtin_nontemporal_store(xv[j], (f32x4*)((float*)xout_ + (size_t)r * D + 4 * lane + 256 * j));
            }
        }
        if (H) {
            float s = 0.f;
#pragma unroll
            for (int j = 0; j < 4; ++j) s += (xv[j][0] * xv[j][0] + xv[j][1] * xv[j][1]) + (xv[j][2] * xv[j][2] + xv[j][3] * xv[j][3]);
            const float rx = 1.0f / sqrtf(wave_sum(s) * (1.0f / D) + RMS_EPS);
#pragma unroll
            for (int j = 0; j < 4; ++j) { const f32x4 h = (xv[j] * rx) * A2[j] + A3[j]; u32x2 w; w.x = cvt_pk_bf16(h[0], h[1]); w.y = cvt_pk_bf16(h[2], h[3]);
                *(u32x2*)(H + (size_t)r * D + 4 * lane + 256 * j) = w; }
        }
    }
}

__device__ __forceinline__ void attn_unit(LAS unsigned char* lds, const bf16* QKV, const bf16* KVC, bf16* O, const float* sink, int unit) {
    const int tid = threadIdx.x, lane = tid & 63, wid = __builtin_amdgcn_readfirstlane(tid >> 6), r32 = lane & 31, hi = lane >> 5;
    const int kvh = unit & 1, nb = (unit >> 1) & 127, b = unit >> 8;
    const int g = wid >> 1, th = wid & 1, h = kvh * 4 + g;
    const size_t t0 = (size_t)b * SEQ + (size_t)nb * 128;
    bf16x8 qf[2][4];
#pragma unroll
    for (int qg = 0; qg < 2; ++qg)
#pragma unroll
        for (int ks = 0; ks < 4; ++ks) qf[qg][ks] = *(const bf16x8*)(QKV + (t0 + th * 64 + qg * 32 + r32) * NIN0 + h * 64 + ks * 16 + hi * 8);
    LAS unsigned char* qlds = lds + 32768 + wid * 8192 + lane * 16;
#pragma unroll
    for (int qg = 0; qg < 2; ++qg)
#pragma unroll
        for (int ks = 0; ks < 4; ++ks) *(LAS bf16x8*)(qlds + (qg * 4 + ks) * 1024) = qf[qg][ks];
    float mrun[2], lrun[2]; f32x16 o[2][2];
    const float sk = sink[h] * LOG2E;
#pragma unroll
    for (int qg = 0; qg < 2; ++qg) { mrun[qg] = sk; lrun[qg] = hi ? 0.f : 1.f;
#pragma unroll
        for (int dg = 0; dg < 2; ++dg)
#pragma unroll
            for (int r = 0; r < 16; ++r) o[dg][qg][r] = 0.f; }
    const int lkey = tid >> 3, lch = tid & 7;
    const unsigned kw_off = (unsigned)(lkey * 128 + ((lch ^ (lkey & 7)) << 4));
    const unsigned vw_off = (unsigned)(8192 + (lch >> 2) * 4096 + lkey * 64 + (lch & 3) * 16);
    u32x4 kreg, vreg;
#define LOAD_TILE(tl_) do { const int tl__ = (tl_); \
        if (tl__ < 6) { \
            const int kpos = (nb - 1) * 128 + tl__ * 64 + lkey; \
            if (kpos >= 0 && kpos < SEQ) { const bf16* p = QKV + ((size_t)b * SEQ + kpos) * NIN0 + 512 + kvh * 64 + lch * 8; kreg = *(const u32x4*)p; vreg = *(const u32x4*)(p + 128); } \
            else { kreg = (u32x4){0, 0, 0, 0}; vreg = (u32x4){0, 0, 0, 0}; } \
        } else { \
            const bf16* p = KVC + ((size_t)b * CTXL + (tl__ - 6) * 64 + lkey) * 256 + kvh * 64 + lch * 8; kreg = *(const u32x4*)p; vreg = *(const u32x4*)(p + 128); \
        } } while (0)
    LOAD_TILE(0);
    const unsigned kr_base = (unsigned)(r32 * 128);
    const unsigned vr_base = (unsigned)(8192 + (4 * hi + ((lane & 15) >> 2)) * 64 + ((lane >> 4) & 1) * 32 + (lane & 3) * 8);
    for (int tl = 0; tl < 10; ++tl) {
        LAS unsigned char* buf = lds + (tl & 1) * 16384;
        *(LAS u32x4*)(buf + kw_off) = kreg; *(LAS u32x4*)(buf + vw_off) = vreg;
        if (tl + 1 < 10) LOAD_TILE(tl + 1);
        __syncthreads();
        int cls = 1;
        if (tl < 6) { const int kpos0 = (nb - 1) * 128 + tl * 64;
            if (kpos0 < 0 || kpos0 >= SEQ || tl < th || tl > th + 4) cls = 0; else cls = (tl == th || tl == th + 4) ? 2 : 1; }
        if (cls != 0) {
        f32x16 sacc[2][2];
#pragma unroll
        for (int kg = 0; kg < 2; ++kg)
#pragma unroll
            for (int qg = 0; qg < 2; ++qg)
#pragma unroll
                for (int r = 0; r < 16; ++r) sacc[kg][qg][r] = -mrun[qg];
#pragma unroll
        for (int kg = 0; kg < 2; ++kg)
#pragma unroll
            for (int ks = 0; ks < 4; ++ks) {
                const bf16x8 kf = *(const LAS bf16x8*)(buf + kr_base + kg * 4096 + ((((ks * 2 + hi) ^ (r32 & 7))) << 4));
#pragma unroll
                for (int qg = 0; qg < 2; ++qg) { const bf16x8 qv = *(const LAS bf16x8*)(qlds + (qg * 4 + ks) * 1024);
                    sacc[kg][qg] = __builtin_amdgcn_mfma_f32_32x32x16_bf16(kf, qv, sacc[kg][qg], 0, 0, 0); }
            }
        bf16x8 pf[2][2][2];
#pragma unroll
        for (int qg = 0; qg < 2; ++qg) {
            if (cls == 2) {
                const int qi = th * 64 + qg * 32 + r32;
#pragma unroll
                for (int kg = 0; kg < 2; ++kg)
#pragma unroll
                    for (int r = 0; r < 16; ++r) { const int kj = tl * 64 + kg * 32 + crow(r, hi);
                        const bool valid = (kj >= qi) && (kj <= qi + 256); sacc[kg][qg][r] = valid ? sacc[kg][qg][r] : -1.0e30f; }
            }
            float mxa = fmaxf(sacc[0][qg][0], sacc[1][qg][0]), mxb = fmaxf(sacc[0][qg][1], sacc[1][qg][1]);
#pragma unroll
            for (int r = 2; r < 16; r += 2) { mxa = fmaxf(fmaxf(mxa, sacc[0][qg][r]), sacc[1][qg][r]); mxb = fmaxf(fmaxf(mxb, sacc[0][qg][r + 1]), sacc[1][qg][r + 1]); }
            float mx = fmaxf(mxa, mxb);
            mx = fmaxf(mx, __shfl_xor(mx, 32));
            if (__any(mx > 0.f)) {
                const float dl = fmaxf(mx, 0.f); mrun[qg] += dl;
                const float alpha = __builtin_amdgcn_exp2f(-dl); lrun[qg] *= alpha;
#pragma unroll
                for (int kg = 0; kg < 2; ++kg)
#pragma unroll
                    for (int r = 0; r < 16; ++r) sacc[kg][qg][r] -= dl;
#pragma unroll
                for (int dg = 0; dg < 2; ++dg)
#pragma unroll
                    for (int r = 0; r < 16; ++r) o[dg][qg][r] *= alpha;
            }
            float psa = 0.f, psb = 0.f;
#pragma unroll
            for (int kg = 0; kg < 2; ++kg)
#pragma unroll
                for (int r = 0; r < 16; r += 2) { const float p0 = __builtin_amdgcn_exp2f(sacc[kg][qg][r]), p1 = __builtin_amdgcn_exp2f(sacc[kg][qg][r + 1]); sacc[kg][qg][r] = p0; sacc[kg][qg][r + 1] = p1; psa += p0; psb += p1; }
            lrun[qg] += psa + psb;
#pragma unroll
            for (int kg = 0; kg < 2; ++kg)
#pragma unroll
                for (int s = 0; s < 2; ++s) { u32x4 w;
                    w.x = cvt_pk_bf16(sacc[kg][qg][8 * s + 0], sacc[kg][qg][8 * s + 1]); w.y = cvt_pk_bf16(sacc[kg][qg][8 * s + 2], sacc[kg][qg][8 * s + 3]);
                    w.z = cvt_pk_bf16(sacc[kg][qg][8 * s + 4], sacc[kg][qg][8 * s + 5]); w.w = cvt_pk_bf16(sacc[kg][qg][8 * s + 6], sacc[kg][qg][8 * s + 7]);
                    pf[kg][qg][s] = __builtin_bit_cast(bf16x8, w); }
        }
#pragma unroll
        for (int dg = 0; dg < 2; ++dg)
#pragma unroll
            for (int kg = 0; kg < 2; ++kg)
#pragma unroll
                for (int s = 0; s < 2; ++s) {
                    const LAS char* vp = (const LAS char*)(buf + vr_base + dg * 4096 + (kg * 32 + 16 * s) * 64);
                    const s16x4 lo = vtr(vp), hi4 = vtr(vp + 512);
                    const bf16x8 vf = (bf16x8){lo[0], lo[1], lo[2], lo[3], hi4[0], hi4[1], hi4[2], hi4[3]};
#pragma unroll
                    for (int qg = 0; qg < 2; ++qg) o[dg][qg] = __builtin_amdgcn_mfma_f32_32x32x16_bf16(vf, pf[kg][qg][s], o[dg][qg], 0, 0, 0);
                }
        }
    }
#pragma unroll
    for (int qg = 0; qg < 2; ++qg) {
        const float lt = lrun[qg] + __shfl_xor(lrun[qg], 32); const float inv = 1.0f / lt;
        bf16* op = O + (t0 + th * 64 + qg * 32 + r32) * D + h * 64 + 4 * hi;
#pragma unroll
        for (int dg = 0; dg < 2; ++dg)
#pragma unroll
            for (int rg = 0; rg < 4; ++rg) { u32x2 w; w.x = cvt_pk_bf16(o[dg][qg][4 * rg] * inv, o[dg][qg][4 * rg + 1] * inv); w.y = cvt_pk_bf16(o[dg][qg][4 * rg + 2] * inv, o[dg][qg][4 * rg + 3] * inv);
                *(u32x2*)(op + dg * 32 + 8 * rg) = w; }
    }
    __syncthreads();
}

__device__ __forceinline__ void gate_unit(LAS unsigned char* lds, const bf16* QKV, bf16* O, const float* vnorm, const bf16* wsg, const float* bsg, int unit) {
    const int tid = threadIdx.x, lane = tid & 63, wid = __builtin_amdgcn_readfirstlane(tid >> 6), r32 = lane & 31, hi = lane >> 5;
    const int g = wid; const size_t t0 = (size_t)unit * 128;
    LAS unsigned char* img = lds + wid * 16384;
    {
        const int d8 = lane & 7;
        const f32x4 n0 = *(const f32x4*)(vnorm + g * 64 + d8 * 8), n1 = *(const f32x4*)(vnorm + g * 64 + d8 * 8 + 4);
#pragma unroll 8
        for (int it = 0; it < 16; ++it) {
            const int j = it * 8 + (lane >> 3);
            const u32x4 w = *(const u32x4*)(QKV + (t0 + j) * NIN0 + 1280 + g * 64 + d8 * 8);
            float v[8] = {bflo(w.x), bfhi(w.x), bflo(w.y), bfhi(w.y), bflo(w.z), bfhi(w.z), bflo(w.w), bfhi(w.w)};
            float s = ((v[0] + v[1]) + (v[2] + v[3])) + ((v[4] + v[5]) + (v[6] + v[7]));
            s += __shfl_xor(s, 1); s += __shfl_xor(s, 2); s += __shfl_xor(s, 4);
            const float mu = s * (1.0f / 64.0f); float q = 0.f;
#pragma unroll
            for (int e = 0; e < 8; ++e) { v[e] -= mu; q += v[e] * v[e]; }
            q += __shfl_xor(q, 1); q += __shfl_xor(q, 2); q += __shfl_xor(q, 4);
            const float rs = 1.0f / sqrtf(q * (1.0f / 64.0f) + LN_EPS);
            u32x4 ow; ow.x = cvt_pk_bf16(v[0] * rs * n0[0], v[1] * rs * n0[1]); ow.y = cvt_pk_bf16(v[2] * rs * n0[2], v[3] * rs * n0[3]);
            ow.z = cvt_pk_bf16(v[4] * rs * n1[0], v[5] * rs * n1[1]); ow.w = cvt_pk_bf16(v[6] * rs * n1[2], v[7] * rs * n1[3]);
            *(LAS u32x4*)(img + (d8 >> 2) * 8192 + j * 64 + (d8 & 3) * 16) = ow;
        }
    }
    __syncthreads();
    const unsigned vr_base = (unsigned)((8 * hi + ((lane & 15) >> 2)) * 64 + ((lane >> 4) & 1) * 32 + (lane & 3) * 8);
    const bf16* wsp = wsg + (size_t)g * 128 * 128;
    bf16x8 vf[2][8];
#pragma unroll
    for (int dg = 0; dg < 2; ++dg)
#pragma unroll
        for (int ks = 0; ks < 8; ++ks) {
            const LAS char* vp = (const LAS char*)(img + vr_base + dg * 8192 + (16 * ks) * 64);
            const s16x4 lo = vtr(vp), hi4 = vtr(vp + 256);
            vf[dg][ks] = (bf16x8){lo[0], lo[1], lo[2], lo[3], hi4[0], hi4[1], hi4[2], hi4[3]};
        }
#pragma unroll 1
    for (int ig = 0; ig < 4; ++ig) {
        const int i = ig * 32 + r32;
        bf16x8 wf[8];
#pragma unroll
        for (int ks = 0; ks < 8; ++ks) wf[ks] = *(const bf16x8*)(wsp + (size_t)i * 128 + ks * 16 + hi * 8);
        const float bias = bsg[g * 128 + i];
        const bf16* up = QKV + (t0 + i) * NIN0 + 768 + g * 64 + 4 * hi;
        u32x2 uw[2][4];
#pragma unroll
        for (int dg = 0; dg < 2; ++dg)
#pragma unroll
            for (int rg = 0; rg < 4; ++rg) uw[dg][rg] = *(const u32x2*)(up + dg * 32 + 8 * rg);
        f32x16 acc0, acc1;
#pragma unroll
        for (int r = 0; r < 16; ++r) { acc0[r] = 0.f; acc1[r] = 0.f; }
#pragma unroll
        for (int ks = 0; ks < 8; ++ks) {
            acc0 = __builtin_amdgcn_mfma_f32_32x32x16_bf16(vf[0][ks], wf[ks], acc0, 0, 0, 0);
            acc1 = __builtin_amdgcn_mfma_f32_32x32x16_bf16(vf[1][ks], wf[ks], acc1, 0, 0, 0);
        }
        bf16* op = O + (t0 + i) * D + 512 + g * 64 + 4 * hi;
#pragma unroll
        for (int rg = 0; rg < 4; ++rg) {
            u32x2 w; w.x = cvt_pk_bf16(bflo(uw[0][rg].x) * (acc0[4 * rg] + bias), bfhi(uw[0][rg].x) * (acc0[4 * rg + 1] + bias)); w.y = cvt_pk_bf16(bflo(uw[0][rg].y) * (acc0[4 * rg + 2] + bias), bfhi(uw[0][rg].y) * (acc0[4 * rg + 3] + bias));
            *(u32x2*)(op + 8 * rg) = w;
            u32x2 w1; w1.x = cvt_pk_bf16(bflo(uw[1][rg].x) * (acc1[4 * rg] + bias), bfhi(uw[1][rg].x) * (acc1[4 * rg + 1] + bias)); w1.y = cvt_pk_bf16(bflo(uw[1][rg].y) * (acc1[4 * rg + 2] + bias), bfhi(uw[1][rg].y) * (acc1[4 * rg + 3] + bias));
            *(u32x2*)(op + 32 + 8 * rg) = w1;
        }
    }
    __syncthreads();
}

struct ConvIn { u32x4 y0, y1, y2, bg; };
__device__ __forceinline__ ConvIn conv_load(const bf16* __restrict__ Y1, const bf16* __restrict__ BG, int it) {
    const int t = it >> 7, c = (it & 127) * 8; const int s = t & (SEQ - 1); ConvIn v;
    v.y1 = *(const u32x4*)(Y1 + (size_t)t * D + c);
    v.y0 = (s > 0) ? *(const u32x4*)(Y1 + (size_t)(t - 1) * D + c) : (u32x4){0, 0, 0, 0};
    v.y2 = (s < SEQ - 1) ? *(const u32x4*)(Y1 + (size_t)(t + 1) * D + c) : (u32x4){0, 0, 0, 0};
    v.bg = *(const u32x4*)(BG + (size_t)t * D + c);
    return v;
}
__device__ __forceinline__ void conv_store(bf16* __restrict__ Z, const float* __restrict__ cw, int it, const ConvIn& v) {
    const int t = it >> 7, c = (it & 127) * 8;
    const f32x4 w0a = *(const f32x4*)(cw + c), w0b = *(const f32x4*)(cw + c + 4), w1a = *(const f32x4*)(cw + D + c), w1b = *(const f32x4*)(cw + D + c + 4), w2a = *(const f32x4*)(cw + 2 * D + c), w2b = *(const f32x4*)(cw + 2 * D + c + 4);
    float r[8];
#pragma unroll
    for (int e = 0; e < 4; ++e) {
        const unsigned a0 = v.y0[e], a1 = v.y1[e], a2 = v.y2[e], gb = v.bg[e];
        const float wl0 = (e < 2) ? w0a[2 * e] : w0b[2 * e - 4], wh0 = (e < 2) ? w0a[2 * e + 1] : w0b[2 * e - 3];
        const float wl1 = (e < 2) ? w1a[2 * e] : w1b[2 * e - 4], wh1 = (e < 2) ? w1a[2 * e + 1] : w1b[2 * e - 3];
        const float wl2 = (e < 2) ? w2a[2 * e] : w2b[2 * e - 4], wh2 = (e < 2) ? w2a[2 * e + 1] : w2b[2 * e - 3];
        r[2 * e] = bflo(gb) * (wl0 * bflo(a0) + wl1 * bflo(a1) + wl2 * bflo(a2));
        r[2 * e + 1] = bfhi(gb) * (wh0 * bfhi(a0) + wh1 * bfhi(a1) + wh2 * bfhi(a2));
    }
    u32x4 w; w.x = cvt_pk_bf16(r[0], r[1]); w.y = cvt_pk_bf16(r[2], r[3]); w.z = cvt_pk_bf16(r[4], r[5]); w.w = cvt_pk_bf16(r[6], r[7]);
    *(u32x4*)(Z + (size_t)t * D + c) = w;
}
__device__ __forceinline__ void conv_pass(const bf16* __restrict__ Y1, const bf16* __restrict__ BG, bf16* __restrict__ Z, const float* __restrict__ cw, int G) {
    const int nitems = T * (D / 8), stride = G * NTHR;
    for (int it = blockIdx.x * NTHR + threadIdx.x; it < nitems; it += 4 * stride) {
        ConvIn v0 = conv_load(Y1, BG, it), v1, v2, v3;
        const bool h1 = it + stride < nitems, h2 = it + 2 * stride < nitems, h3 = it + 3 * stride < nitems;
        if (h1) v1 = conv_load(Y1, BG, it + stride);
        if (h2) v2 = conv_load(Y1, BG, it + 2 * stride);
        if (h3) v3 = conv_load(Y1, BG, it + 3 * stride);
        conv_store(Z, cw, it, v0);
        if (h1) conv_store(Z, cw, it + stride, v1);
        if (h2) conv_store(Z, cw, it + 2 * stride, v2);
        if (h3) conv_store(Z, cw, it + 3 * stride, v3);
    }
}

constexpr int N_PHASES = 16;
__global__ void __launch_bounds__(NTHR, 2) fwd_megakernel(Args a) {
    extern __shared__ __attribute__((aligned(16))) unsigned char lds_raw[];
    LAS unsigned char* lds = (LAS unsigned char*)lds_raw;
    cg::grid_group grid = cg::this_grid();
    const int G = gridDim.x; int bx = blockIdx.x; bool xl = false; unsigned half = 0u;
    unsigned char* ws = a.ws;
    const float* mod = (const float*)(ws + WS_MOD); const float* modc = (const float*)(ws + WS_MODC); const float* rope = (const float*)(ws + WS_ROPE);
    bf16* Win_t = (bf16*)(ws + WS_WIN); bf16* Wout_t = (bf16*)(ws + WS_WOUT); bf16* SCin_t = (bf16*)(ws + WS_SCIN); bf16* SCout_t = (bf16*)(ws + WS_SCOUT);
    bf16* KVC = (bf16*)(ws + WS_KVC); bf16* H = (bf16*)(ws + WS_H); bf16* BIG = (bf16*)(ws + WS_BIG); bf16* OB = (bf16*)(ws + WS_O); bf16* YB = (bf16*)(ws + WS_Y); bf16* XB = (bf16*)(ws + WS_XB);
    bf16* QKVB = (bf16*)a.out;
    const int lo = a.ph_lo, hi = a.ph_hi;
    volatile LAS unsigned* bst = (volatile LAS unsigned*)(lds + 131072 + 1024);
    if (threadIdx.x < 4) bst[threadIdx.x] = 0u;
    __syncthreads();
    if (lo == 0 && hi > 1) { if (blockIdx.x == 0) for (int w = threadIdx.x; w < XL_WORDS; w += NTHR) __hip_atomic_store((unsigned*)(ws + WS_CTL) + w, 0u, __ATOMIC_RELAXED, __HIP_MEMORY_SCOPE_AGENT); }
    XcdBarrier bar; bar.bar = (unsigned*)(ws + WS_CTL); bar.x = 0; bar.st = bst;
#define IN(k) (lo <= (k) && (k) < hi)
#define SEAM(k) do { if (IN(k) && IN((k) + 1)) { if (xl) xcd_half_barrier(bar, half); else xcd_barrier(bar); } } while (0)
#define SEAML(k) do { if (IN(k) && IN((k) + 1)) { if (xl) xcd_local_barrier(bar); else xcd_barrier(bar); } } while (0)

    if (IN(0)) { p0_prologue(a, lds, G); }
    if (IN(0) && IN(1)) {
        grid.sync();
        bar = xcd_barrier_post((unsigned*)(ws + WS_CTL), bst);
        xcd_barrier(bar);
        if (threadIdx.x == 0) {
            bool okc = (G == 256);
            for (int j = 0; j < 16; ++j) { const unsigned cnt = xb_ld((unsigned*)(ws + WS_CTL) + XB_XCNT(j)); okc = okc && (cnt == (j < 8 ? (unsigned)(G / 8) : 0u)); }
            okc = okc && (xb_ld((unsigned*)(ws + WS_CTL) + XB_TMO) == 0u);
            bst[3] = okc ? 1u : 0u;
        }
        __syncthreads();
        xl = bst[3] != 0u;
        if (xl) { bx = (int)bst[2] * 8 + (int)bar.x; half = bar.x >> 2; }
        const int wv = __builtin_amdgcn_readfirstlane(threadIdx.x >> 6);
        if (!xl) late_transposes(a, lds, bx * NWAVES + wv, G * NWAVES);
        else if (half == 1u) late_transposes(a, lds, ((bx >> 3) * 4 + ((bx & 7) - 4)) * NWAVES + wv, (G / 2) * NWAVES);
        __syncthreads();
    }
    if (IN(1)) {
        rowpass<false, false>(a.x, nullptr, nullptr, H, nullptr, nullptr, a.g_mix_pre, mod + 1024, mod + 0, 6144, T, SEQ, G, bx);
        if (!xl) rowpass<false, false>(a.ctx, nullptr, nullptr, H + (size_t)T * D, nullptr, nullptr, a.g_mix_pre, modc + 1024, modc + 0, 0, TC, TC, G, bx);
        else rowpass<false, false>(a.ctx + (size_t)half * CTXL * D, nullptr, nullptr, H + ((size_t)T + half * CTXL) * D, nullptr, nullptr, a.g_mix_pre, modc + 1024, modc + 0, 0, CTXL, CTXL, G / 2, (bx >> 3) * 4 + ((bx & 7) & 3));
    } SEAM(1);
    if (IN(1) && IN(2) && xl && half == 1u && threadIdx.x == 0) xb_add((unsigned*)(ws + WS_CTL) + XW_FLAG, 1u);
    if (IN(2)) {
        { pg8::Gemm g{H, Win_t, T, NIN0, D}; pg8::StaticOrder S; S.init(T, NIN0, G, bx);
          pg8::EpiInProj E{QKVB, NIN0, rope, SEQ};
          pg8::gemm_phase<pg8::EpiInProj, pg8::StaticOrder, true, true>(lds, g, S, E); }
        { pg8::Gemm g{H + (size_t)T * D, Win_t + (size_t)512 * D, TC, 256, D}; pg8::TailOrder S{G, bx, 2};
          pg8::EpiBf16 E{KVC, 256};
          pg8::gemm_phase<pg8::EpiBf16, pg8::TailOrder, true, true>(lds, g, S, E); }
    } SEAM(2);
    if (IN(3)) {
        __syncthreads();
        const int vbx = (G % 8 == 0) ? (bx % 8) * (G / 8) + bx / 8 : bx;
        for (int tb = vbx; tb < 256; tb += G) {
            attn_unit(lds, QKVB, KVC, OB, a.a_sink, ((tb >> 7) << 8) | ((tb & 127) << 1) | 0);
            attn_unit(lds, QKVB, KVC, OB, a.a_sink, ((tb >> 7) << 8) | ((tb & 127) << 1) | 1);
            gate_unit(lds, QKVB, OB, a.gm_v_norm, (const bf16*)(ws + WS_WSB), a.gm_bs, tb);
        }
    } SEAML(3);
    if (IN(4)) {
        pg8::Gemm g{OB, Wout_t, T, D, D}; pg8::StaticOrder S; S.init(T, D, G, bx); pg8::EpiBf16 E{YB, D};
        pg8::gemm_phase<pg8::EpiBf16, pg8::StaticOrder, true, true>(lds, g, S, E);
    } SEAML(4);
    if (IN(5)) {
        rowpass<false, true>(a.x, YB, XB, H, a.g_mix_post, mod + 2048, a.g_ffn_pre, mod + 4096, mod + 3072, 6144, T, SEQ, G, bx);
    } SEAML(5);
    if (IN(6) && xl && half == 0u) {
        if (threadIdx.x == 0) { unsigned* ctl_ = (unsigned*)(ws + WS_CTL); XB_SPIN(xb_ld(&ctl_[XW_FLAG]) < (unsigned)(G / 2), ctl_); __builtin_amdgcn_fence(__ATOMIC_ACQUIRE, "agent"); asm volatile("s_waitcnt vmcnt(0)" ::: "memory"); }
        __syncthreads();
    }
    if (IN(6)) {
        pg8::Gemm gu{H, (bf16*)(ws + WS_W13), T, 2 * DFF, D}; pg8::EpiPair<1> Eu{BIG, DFF, 1 << 30, nullptr, 0};
        pg8::Gemm gd{BIG, (bf16*)(ws + WS_W2), T, D, DFF}; pg8::EpiBf16 Ed{YB, D};
        if (G == 256) {
            { pg8::StaticOrder S; S.init(T, 2 * DFF, G, bx); S.window(0, 6); pg8::gemm_phase<pg8::EpiPair<1>, pg8::StaticOrder, true, true>(lds, gu, S, Eu); }
            if (xl) xcd_local_barrier(bar); else xcd_barrier(bar);
            { pg8::StaticOrder S; S.init(T, D, G, bx); S.window(0, 1); pg8::gemm_phase<pg8::EpiBf16, pg8::StaticOrder, true, true>(lds, gd, S, Ed); }
            if (xl) xcd_local_barrier(bar); else xcd_barrier(bar);
            { pg8::StaticOrder S; S.init(T, 2 * DFF, G, bx); S.window(6, 11); pg8::gemm_phase<pg8::EpiPair<1>, pg8::StaticOrder, true, true>(lds, gu, S, Eu); }
        } else {
            pg8::StaticOrder S; S.init(T, 2 * DFF, G, bx); pg8::gemm_phase<pg8::EpiPair<1>, pg8::StaticOrder, true, true>(lds, gu, S, Eu);
        }
    } SEAML(6);
    if (IN(7)) {
        pg8::Gemm gd{BIG, (bf16*)(ws + WS_W2), T, D, DFF}; pg8::EpiBf16 Ed{YB, D};
        pg8::StaticOrder S; S.init(T, D, G, bx, G == 256 ? 0 : 1); if (G == 256) S.window(1, 2);
        pg8::gemm_phase<pg8::EpiBf16, pg8::StaticOrder, true, true>(lds, gd, S, Ed);
    } SEAML(7);
    if (IN(8)) {
        rowpass<true, true>(XB, YB, XB, H, a.g_ffn_post, mod + 5120, a.g_mix_pre + D, mod + 2 * 6144 + 1024, mod + 2 * 6144 + 0, 6144, T, SEQ, G, bx);
    } SEAML(8);
    if (IN(9)) {
        pg8::Gemm g{H, SCin_t, T, 2048, D}; pg8::StaticOrder S; S.init(T, 2048, G, bx); pg8::EpiPair<0> E{YB, D, 1 << 30, nullptr, 0};
        pg8::gemm_phase<pg8::EpiPair<0>, pg8::StaticOrder, true, true>(lds, g, S, E);
    } SEAM(9);
    if (IN(10)) {
        pg8::Gemm g{H, SCin_t + (size_t)2048 * D, T, D, D}; pg8::StaticOrder S; S.init(T, D, G, bx); pg8::EpiConv E{YB, OB, a.sc_conv, D, SEQ};
        pg8::gemm_phase<pg8::EpiConv, pg8::StaticOrder, true, true>(lds, g, S, E);
    } SEAM(10);
    if (IN(11)) {
        pg8::Gemm g{OB, SCout_t, T, D, D}; pg8::StaticOrder S; S.init(T, D, G, bx); pg8::EpiBf16 E{YB, D};
        pg8::gemm_phase<pg8::EpiBf16, pg8::StaticOrder, true, true>(lds, g, S, E);
    } SEAML(11);
    if (IN(12)) {
        rowpass<true, true>(XB, YB, XB, H, a.g_mix_post + D, mod + 2 * 6144 + 2048, a.g_ffn_pre + D, mod + 2 * 6144 + 4096, mod + 2 * 6144 + 3072, 6144, T, SEQ, G, bx);
    } SEAML(12);
    if (IN(13)) {
        pg8::Gemm gu{H, (bf16*)(ws + WS_W13 + 11 * MiB), T, 2 * DFF, D}; pg8::EpiPair<1> Eu{BIG, DFF, 1 << 30, nullptr, 0};
        pg8::Gemm gd{BIG, (bf16*)(ws + WS_W2 + 6 * MiB), T, D, DFF}; pg8::EpiBf16 Ed{YB, D};
        if (G == 256) {
            { pg8::StaticOrder S; S.init(T, 2 * DFF, G, bx); S.window(0, 6); pg8::gemm_phase<pg8::EpiPair<1>, pg8::StaticOrder, true, true>(lds, gu, S, Eu); }
            if (xl) xcd_local_barrier(bar); else xcd_barrier(bar);
            { pg8::StaticOrder S; S.init(T, D, G, bx); S.window(0, 1); pg8::gemm_phase<pg8::EpiBf16, pg8::StaticOrder, true, true>(lds, gd, S, Ed); }
            if (xl) xcd_local_barrier(bar); else xcd_barrier(bar);
            { pg8::StaticOrder S; S.init(T, 2 * DFF, G, bx); S.window(6, 11); pg8::gemm_phase<pg8::EpiPair<1>, pg8::StaticOrder, true, true>(lds, gu, S, Eu); }
        } else {
            pg8::StaticOrder S; S.init(T, 2 * DFF, G, bx); pg8::gemm_phase<pg8::EpiPair<1>, pg8::StaticOrder, true, true>(lds, gu, S, Eu);
        }
    } SEAML(13);
    if (IN(14)) {
        pg8::Gemm gd{BIG, (bf16*)(ws + WS_W2 + 6 * MiB), T, D, DFF}; pg8::EpiBf16 Ed{YB, D};
        pg8::StaticOrder S; S.init(T, D, G, bx, G == 256 ? 0 : 1); if (G == 256) S.window(1, 2);
        pg8::gemm_phase<pg8::EpiBf16, pg8::StaticOrder, true, true>(lds, gd, S, Ed);
    } SEAML(14);
    if (IN(15)) {
        rowpass<true, false>(XB, YB, a.out, nullptr, a.g_ffn_post + D, mod + 2 * 6144 + 5120, nullptr, nullptr, nullptr, 6144, T, SEQ, G, bx);
    }
#undef IN
#undef SEAM
}

#ifndef MK_MULTI
#define MK_MULTI 0
#endif
extern "C" void kernel_launch(void* const* d_in, const int* in_sizes, int n_in, void* d_out, int out_size, void* d_ws, size_t ws_size, hipStream_t stream) {
    static int grid = 0;
    if (grid == 0) {
        if (n_in != 22 || out_size != T * D || ws_size < WS_END) { fprintf(stderr, "kernel_launch: unexpected shapes (n_in %d out %d ws %zu)\n", n_in, out_size, ws_size); grid = -1; return; }
        int dev = 0, cus = 0, per_cu = 0;
        hipGetDevice(&dev); hipDeviceGetAttribute(&cus, hipDeviceAttributeMultiprocessorCount, dev);
        hipFuncSetAttribute((const void*)fwd_megakernel, hipFuncAttributeMaxDynamicSharedMemorySize, LDS_BYTES);
        hipOccupancyMaxActiveBlocksPerMultiprocessor(&per_cu, (const void*)fwd_megakernel, NTHR, LDS_BYTES);
        if (per_cu < 1) { fprintf(stderr, "kernel_launch: occupancy query says %d blocks/CU\n", per_cu); per_cu = 1; }
        if (per_cu > 1) per_cu = 1;
        grid = cus * per_cu;
        (void)hipGetLastError();
    }
    if (grid < 0) return;
    Args a{};
    const float** ap = (const float**)&a;
    for (int i = 0; i < 22; ++i) ap[i] = (const float*)d_in[i];
    a.out = (float*)d_out; a.ws = (unsigned char*)d_ws;
#if MK_MULTI
    for (int p = 0; p < N_PHASES; ++p) { a.ph_lo = p; a.ph_hi = p + 1; hipLaunchKernelGGL(fwd_megakernel, dim3(grid), dim3(NTHR), LDS_BYTES, stream, a); }
#else
    a.ph_lo = 0; a.ph_hi = N_PHASES;
    void* args[] = {&a};
    hipError_t e = hipLaunchCooperativeKernel((const void*)fwd_megakernel, dim3(grid), dim3(NTHR), args, LDS_BYTES, stream);
    if (e != hipSuccess) fprintf(stderr, "cooperative launch failed: %s (grid %d)\n", hipGetErrorString(e), grid);
#endif
}
```

```cpp
#include <hip/hip_runtime.h>
#include <hip/hip_cooperative_groups.h>
#include <cstdio>
#include <cstdint>
namespace cg = cooperative_groups;

namespace pg8 {
#define PG8_LAS __attribute__((address_space(3)))
typedef unsigned short bf16_t;
typedef short bf16x8 __attribute__((ext_vector_type(8)));
typedef float f32x4 __attribute__((ext_vector_type(4)));
typedef unsigned u32x4 __attribute__((ext_vector_type(4)));
constexpr int BM = 256, BK = 64, HALF = 128, HTB = HALF * BK * 2  , STAGE_BYTES = 8 * HTB, NXCD = 8, WGM = 8;

__host__ __device__ __forceinline__ int lds_byte(int r, int c) { const int st = (r >> 4) * 2 + (c >> 5), rr = r & 15, cc = c & 31, ob = rr * 64 + cc * 2; return st * 1024 + (ob ^ (((ob >> 9) & 1) << 5)); }
__host__ __device__ __forceinline__ void stage_rc(int b, int& R, int& C) { const int st = b / 1024, sb = b % 1024, swz = sb ^ (((sb >> 9) & 1) << 5); R = (st >> 1) * 16 + swz / 64; C = (st & 1) * 32 + (swz % 64) / 2; }
__host__ __device__ __forceinline__ int perm32(int rho) { const int n = rho >> 4, i = rho & 15; return 8 * (i >> 2) + 4 * n + (i & 3); }

struct Unit { int pm, pn; };
struct Gemm { const bf16_t* A; const bf16_t* Bt; int M, N, K; };

struct StaticOrder {
    int nM, nN, nwg, G, c, rev, i0, i1;
    __host__ __device__ __forceinline__ void init(int M, int N, int G_, int c_, int rev_ = 0) { nM = M / BM; nN = N / BM; nwg = nM * nN; G = G_; c = c_; rev = (rev_ && (nwg % G_ == 0)) ? nwg / G_ : 0; i0 = 0; i1 = 1 << 30; }
    __host__ __device__ __forceinline__ void window(int a, int b) { i0 = a; i1 = b; }
    __host__ __device__ __forceinline__ bool next(int i_, Unit& u) const {
        const int i = i_ + i0; if (i >= i1) return false;
        if (rev && i >= rev) return false;
        const long L = (long)(rev ? (rev - 1 - i) : i) * G + c; if (L >= nwg) return false;
        int wgid = (int)L; { const int q = nwg / NXCD, r = nwg % NXCD, xcd = wgid % NXCD, off = wgid / NXCD; wgid = (xcd < r ? xcd * (q + 1) : r * (q + 1) + (xcd - r) * q) + off; }
        const int nig = WGM * nN, gid = wgid / nig, fm = gid * WGM, gsz = (nM - fm) < WGM ? (nM - fm) : WGM;
        u.pm = fm + ((wgid % nig) % gsz); u.pn = (wgid % nig) / gsz; return true;
    }
    __device__ __forceinline__ void a_ready(const Unit&) const {}
    __device__ __forceinline__ void done(const Unit&) const {}
};
struct TailOrder {
    int G, c, n;
    __device__ __forceinline__ bool next(int i, Unit& u) const { if (i != 0) return false; const int c0 = (G >= 8) ? G - 5 : G - 2; int k = -1; if (c == c0) k = 0; else if (c == G - 1) k = 1; if (k < 0 || k >= n) return false; u.pm = k; u.pn = 0; return true; }
    __device__ __forceinline__ void a_ready(const Unit&) const {}
    __device__ __forceinline__ void done(const Unit&) const {}
};

typedef float f32x2_t __attribute__((ext_vector_type(2))); typedef __bf16 bf16x2_t __attribute__((ext_vector_type(2)));
__device__ __forceinline__ unsigned cvt_pk_bf16(float lo, float hi) { f32x2_t v = {lo, hi}; bf16x2_t b = __builtin_convertvector(v, bf16x2_t); return __builtin_bit_cast(unsigned, b); }


struct EpiBf16 {
    static constexpr bool PERM = true, AFTER_DRAIN = false;
    bf16_t* O; int ldc;
    __device__ __forceinline__ void operator()(const f32x4 (&acc)[2][2][4][2], const Unit& u, int wr, int wc, int fr, int fq) const {
        const int row0 = u.pm * BM + wr * 64 + fr; const int col0 = u.pn * BM + wc * 32 + 8 * fq;
#pragma unroll
        for (int ai = 0; ai < 2; ++ai)
#pragma unroll
            for (int m = 0; m < 4; ++m) { bf16_t* rowp = O + (size_t)(row0 + ai * HALF + m * 16) * ldc + col0;
#pragma unroll
                for (int bj = 0; bj < 2; ++bj) { const f32x4 v0 = acc[ai][bj][m][0], v1 = acc[ai][bj][m][1];
                    u32x4 w; w.x = cvt_pk_bf16(v0[0], v0[1]); w.y = cvt_pk_bf16(v0[2], v0[3]); w.z = cvt_pk_bf16(v1[0], v1[1]); w.w = cvt_pk_bf16(v1[2], v1[3]);
                    *(u32x4*)(rowp + bj * HALF) = w; } }
    }
};
template <int ACT> struct EpiPair {
    static constexpr bool PERM = true, AFTER_DRAIN = false;
    bf16_t* O; int ldc; int npair; bf16_t* O2; int ldc2;
    __device__ __forceinline__ void operator()(const f32x4 (&acc)[2][2][4][2], const Unit& u, int wr, int wc, int fr, int fq) const {
        const int row0 = u.pm * BM + wr * 64 + fr;
        if (u.pn < npair) {
            const int col0 = u.pn * HALF + wc * 32 + 8 * fq;
#pragma unroll
            for (int ai = 0; ai < 2; ++ai)
#pragma unroll
                for (int m = 0; m < 4; ++m) { bf16_t* rowp = O + (size_t)(row0 + ai * HALF + m * 16) * ldc + col0; float r[8];
#pragma unroll
                    for (int n = 0; n < 2; ++n)
#pragma unroll
                        for (int j = 0; j < 4; ++j) { float a = acc[ai][0][m][n][j]; const float b = acc[ai][1][m][n][j];
                            if (ACT == 1) a = a * __builtin_amdgcn_rcpf(1.0f + __builtin_amdgcn_exp2f(-1.4426950408889634f * a));
                            r[n * 4 + j] = a * b; }
                    u32x4 w; w.x = cvt_pk_bf16(r[0], r[1]); w.y = cvt_pk_bf16(r[2], r[3]); w.z = cvt_pk_bf16(r[4], r[5]); w.w = cvt_pk_bf16(r[6], r[7]);
                    *(u32x4*)rowp = w; }
        } else {
            const int col0 = (u.pn - npair) * BM + wc * 32 + 8 * fq;
#pragma unroll
            for (int ai = 0; ai < 2; ++ai)
#pragma unroll
                for (int m = 0; m < 4; ++m) { bf16_t* rowp = O2 + (size_t)(row0 + ai * HALF + m * 16) * ldc2 + col0;
#pragma unroll
                    for (int bj = 0; bj < 2; ++bj) { const f32x4 v0 = acc[ai][bj][m][0], v1 = acc[ai][bj][m][1];
                        u32x4 w; w.x = cvt_pk_bf16(v0[0], v0[1]); w.y = cvt_pk_bf16(v0[2], v0[3]); w.z = cvt_pk_bf16(v1[0], v1[1]); w.w = cvt_pk_bf16(v1[2], v1[3]);
                        *(u32x4*)(rowp + bj * HALF) = w; } }
        }
    }
};
struct EpiConv {
    static constexpr bool PERM = true, AFTER_DRAIN = false;
    const bf16_t* Y1; bf16_t* Z; const float* cw; int ld; int seq;
    __device__ __forceinline__ void operator()(const f32x4 (&acc)[2][2][4][2], const Unit& u, int wr, int wc, int fr, int fq) const {
        const int row0 = u.pm * BM + wr * 64 + fr;
#pragma unroll
        for (int bj = 0; bj < 2; ++bj) {
            const int col = u.pn * BM + bj * HALF + wc * 32 + 8 * fq;
            const f32x4 w0a = *(const f32x4*)(cw + col), w0b = *(const f32x4*)(cw + col + 4), w1a = *(const f32x4*)(cw + ld + col), w1b = *(const f32x4*)(cw + ld + col + 4),
                        w2a = *(const f32x4*)(cw + 2 * ld + col), w2b = *(const f32x4*)(cw + 2 * ld + col + 4);
#pragma unroll
            for (int ai = 0; ai < 2; ++ai)
#pragma unroll
                for (int m = 0; m < 4; ++m) {
                    const int row = row0 + ai * HALF + m * 16; const int s = row & (seq - 1);
                    const bf16_t* yp = Y1 + (size_t)row * ld + col;
                    const u32x4 y1 = *(const u32x4*)yp;
                    const u32x4 y0 = (s > 0) ? *(const u32x4*)(yp - ld) : (u32x4){0, 0, 0, 0};
                    const u32x4 y2 = (s < seq - 1) ? *(const u32x4*)(yp + ld) : (u32x4){0, 0, 0, 0};
                    const f32x4 b0 = acc[ai][bj][m][0], b1 = acc[ai][bj][m][1];
                    float r[8];
#pragma unroll
                    for (int e = 0; e < 4; ++e) {
                        const float l0 = __uint_as_float(y0[e] << 16), h0 = __uint_as_float(y0[e] & 0xffff0000u);
                        const float l1 = __uint_as_float(y1[e] << 16), h1 = __uint_as_float(y1[e] & 0xffff0000u);
                        const float l2 = __uint_as_float(y2[e] << 16), h2 = __uint_as_float(y2[e] & 0xffff0000u);
                        const float wl0 = (e < 2) ? w0a[2 * e] : w0b[2 * e - 4], wh0 = (e < 2) ? w0a[2 * e + 1] : w0b[2 * e - 3];
                        const float wl1 = (e < 2) ? w1a[2 * e] : w1b[2 * e - 4], wh1 = (e < 2) ? w1a[2 * e + 1] : w1b[2 * e - 3];
                        const float wl2 = (e < 2) ? w2a[2 * e] : w2b[2 * e - 4], wh2 = (e < 2) ? w2a[2 * e + 1] : w2b[2 * e - 3];
                        const float bl = (e < 2) ? b0[2 * e] : b1[2 * e - 4], bh = (e < 2) ? b0[2 * e + 1] : b1[2 * e - 3];
                        r[2 * e] = bl * (wl0 * l0 + wl1 * l1 + wl2 * l2);
                        r[2 * e + 1] = bh * (wh0 * h0 + wh1 * h1 + wh2 * h2);
                    }
                    u32x4 w; w.x = cvt_pk_bf16(r[0], r[1]); w.y = cvt_pk_bf16(r[2], r[3]); w.z = cvt_pk_bf16(r[4], r[5]); w.w = cvt_pk_bf16(r[6], r[7]);
                    *(u32x4*)(Z + (size_t)row * ld + col) = w;
                }
        }
    }
};
struct EpiInProj {
    static constexpr bool PERM = true, AFTER_DRAIN = false;
    bf16_t* O; int ldc; const float* rope; int seq;
    __device__ __forceinline__ void operator()(const f32x4 (&acc)[2][2][4][2], const Unit& u, int wr, int wc, int fr, int fq) const {
        const int row0 = u.pm * BM + wr * 64 + fr; const int col0 = u.pn * BM + wc * 32 + 8 * fq;
        const int axis = wc & 1; const float sgn = (fq & 2) ? 1.0f : -1.0f; const int i0 = 8 * (fq & 1);
#pragma unroll
        for (int ai = 0; ai < 2; ++ai)
#pragma unroll
            for (int m = 0; m < 4; ++m) { const int row = row0 + ai * HALF + m * 16; bf16_t* rowp = O + (size_t)row * ldc + col0;
                const int s = row % seq; const int pos = axis ? (s & 63) : (s >> 6);
                const f32x4* rp = (const f32x4*)(rope + ((size_t)pos * 16 + i0) * 2);
#pragma unroll
                for (int bj = 0; bj < 2; ++bj) { f32x4 v0 = acc[ai][bj][m][0], v1 = acc[ai][bj][m][1];
                    const bool do_rope = (u.pn < 2) || (u.pn == 2 && bj == 0);
                    if (do_rope) {
                        const f32x4 cs0 = rp[0], cs1 = rp[1], cs2 = rp[2], cs3 = rp[3];
                        f32x4 p0, p1;
#pragma unroll
                        for (int j = 0; j < 4; ++j) { p0[j] = __shfl_xor(v0[j], 32); p1[j] = __shfl_xor(v1[j], 32); }
                        const float sc = (u.pn < 2) ? 0.125f * 1.4426950408889634f : 1.0f;
                        v0[0] = (v0[0] * cs0[0] + sgn * p0[0] * cs0[1]) * sc; v0[1] = (v0[1] * cs0[2] + sgn * p0[1] * cs0[3]) * sc;
                        v0[2] = (v0[2] * cs1[0] + sgn * p0[2] * cs1[1]) * sc; v0[3] = (v0[3] * cs1[2] + sgn * p0[3] * cs1[3]) * sc;
                        v1[0] = (v1[0] * cs2[0] + sgn * p1[0] * cs2[1]) * sc; v1[1] = (v1[1] * cs2[2] + sgn * p1[1] * cs2[3]) * sc;
                        v1[2] = (v1[2] * cs3[0] + sgn * p1[2] * cs3[1]) * sc; v1[3] = (v1[3] * cs3[2] + sgn * p1[3] * cs3[3]) * sc;
                    }
                    u32x4 w; w.x = cvt_pk_bf16(v0[0], v0[1]); w.y = cvt_pk_bf16(v0[2], v0[3]); w.z = cvt_pk_bf16(v1[0], v1[1]); w.w = cvt_pk_bf16(v1[2], v1[3]);
                    *(u32x4*)(rowp + bj * HALF) = w; } }
    }
};

template <class Epi, class Sched, bool ALIGN_EPI = false, bool SP2 = false>
__device__ __forceinline__ void gemm_phase(PG8_LAS unsigned char* lds, const Gemm g, const Sched& S, const Epi& E) {
    const int tid = threadIdx.x, wid = __builtin_amdgcn_readfirstlane(tid >> 6), lane = tid & 63, wr = wid >> 2, wc = wid & 3, fr = lane & 15, fq = lane >> 4;
    const int K = g.K, nt = K / BK;
    unsigned voffA[2], voffB[2];
#pragma unroll
    for (int i = 0; i < 2; ++i) { int R, C; stage_rc(tid * 16 + i * 8192, R, C); const int Rb = Epi::PERM ? ((R & ~31) + perm32(R & 31)) : R;
        voffA[i] = (unsigned)(R * K + C) * 2u; voffB[i] = (unsigned)(Rb * K + C) * 2u; }
    const size_t kstep = (size_t)(BK * 2);
    const size_t hstep = (size_t)HALF * K * 2;
    const size_t tstep = 2 * hstep;
    const unsigned ldsw = (unsigned)wid * 1024u;
    const int aoff = lds_byte(wr * 64 + fr, fq * 8), boff = lds_byte(wc * 32 + fr, fq * 8);
#define PG8_SA(b, h) (((b) * 2 + (h)) * HTB)
#define PG8_SB(b, h) ((4 + (b) * 2 + (h)) * HTB)
#define PG8_STAGE(bufoff, gbase, voff) do { _Pragma("unroll") for (int _i = 0; _i < 2; ++_i) \
        __builtin_amdgcn_global_load_lds((const unsigned*)((const char*)(gbase) + (voff)[_i]), (PG8_LAS unsigned*)(lds + (bufoff) + ldsw + _i * 8192), 16, 0, 0); } while (0)
#define PG8_LDA(dst, b, h) do { _Pragma("unroll") for (int m = 0; m < 4; ++m) _Pragma("unroll") for (int k = 0; k < 2; ++k) dst[m][k] = *(const PG8_LAS bf16x8*)(lds + PG8_SA(b, h) + aoff + m * 2048 + k * 1024); } while (0)
#define PG8_LDB(dst, b, h) do { _Pragma("unroll") for (int n = 0; n < 2; ++n) _Pragma("unroll") for (int k = 0; k < 2; ++k) dst[n][k] = *(const PG8_LAS bf16x8*)(lds + PG8_SB(b, h) + boff + n * 2048 + k * 1024); } while (0)
#define PG8_MMA(ai, bj, At, Bt) do { __builtin_amdgcn_s_setprio(1); _Pragma("unroll") for (int m = 0; m < 4; ++m) _Pragma("unroll") for (int n = 0; n < 2; ++n) _Pragma("unroll") for (int k = 0; k < 2; ++k) \
        acc[ai][bj][m][n] = __builtin_amdgcn_mfma_f32_16x16x32_bf16(Bt[n][k], At[m][k], acc[ai][bj][m][n], 0, 0, 0); __builtin_amdgcn_s_setprio(0); } while (0)
#define PG8_WAIT_V(n) asm volatile("s_waitcnt vmcnt(" #n ")" ::: "memory")
#define PG8_WAIT_L(n) asm volatile("s_waitcnt lgkmcnt(" #n ")" ::: "memory")
#define PG8_BAR __builtin_amdgcn_s_barrier()
#define PG8_SCHED __builtin_amdgcn_sched_barrier(0)
    Unit cur, nxt; int ui = 0;
    if (!S.next(0, cur)) return;
    f32x4 acc[2][2][4][2];
#pragma unroll
    for (int a = 0; a < 2; ++a)
#pragma unroll
        for (int b = 0; b < 2; ++b)
#pragma unroll
            for (int m = 0; m < 4; ++m)
#pragma unroll
                for (int n = 0; n < 2; ++n) acc[a][b][m][n] = (f32x4){0.f, 0.f, 0.f, 0.f};
    bf16x8 At[4][2], B0[2][2], B1[2][2];
    const char* cA = (const char*)g.A + (size_t)cur.pm * tstep; const char* cB = (const char*)g.Bt + (size_t)cur.pn * tstep;
    S.a_ready(cur);
    if constexpr (SP2) {
        PG8_STAGE(PG8_SB(0, 0), cB, voffB); PG8_STAGE(PG8_SB(0, 1), cB + hstep, voffB); PG8_STAGE(PG8_SA(0, 0), cA, voffA); PG8_STAGE(PG8_SA(0, 1), cA + hstep, voffA);
        if (wr == 1) PG8_BAR;
        PG8_WAIT_V(2); PG8_BAR;
        PG8_STAGE(PG8_SB(1, 0), cB + kstep, voffB); PG8_STAGE(PG8_SA(1, 0), cA + kstep, voffA); PG8_STAGE(PG8_SB(1, 1), cB + hstep + kstep, voffB);
        PG8_WAIT_V(6); PG8_BAR;
    } else {
        PG8_STAGE(PG8_SB(0, 0), cB, voffB); PG8_STAGE(PG8_SA(0, 0), cA, voffA); PG8_STAGE(PG8_SB(0, 1), cB + hstep, voffB); PG8_STAGE(PG8_SA(0, 1), cA + hstep, voffA);
        if (wr == 1) PG8_BAR;
        PG8_WAIT_V(4); PG8_BAR;
        PG8_STAGE(PG8_SB(1, 0), cB + kstep, voffB); PG8_STAGE(PG8_SA(1, 0), cA + kstep, voffA); PG8_STAGE(PG8_SB(1, 1), cB + hstep + kstep, voffB);
        PG8_WAIT_V(6); PG8_BAR;
    }
    for (;;) {
        const bool has_next = S.next(ui + 1, nxt);
        const char* nA = has_next ? (const char*)g.A + (size_t)nxt.pm * tstep : cA; const char* nB = has_next ? (const char*)g.Bt + (size_t)nxt.pn * tstep : cB;
        for (int t = 0; t < nt; t += 2) {
            const bool last = (t == nt - 2);
            const char* a1 = cA + (size_t)(t + 1) * kstep;
            const char* a2 = last ? nA : cA + (size_t)(t + 2) * kstep; const char* b2 = last ? nB : cB + (size_t)(t + 2) * kstep;
            const char* a3 = a2 + kstep; const char* b3 = b2 + kstep;
            if (last && has_next) S.a_ready(nxt);
            if constexpr (SP2) {
            PG8_LDB(B0, 0, 0); PG8_LDB(B1, 0, 1); PG8_SCHED; PG8_LDA(At, 0, 0); PG8_STAGE(PG8_SA(1, 1), a1 + hstep, voffA);
            PG8_WAIT_V(8); PG8_WAIT_L(0); PG8_BAR; PG8_MMA(0, 0, At, B0); PG8_MMA(0, 1, At, B1); PG8_BAR; PG8_SCHED;
            PG8_LDA(At, 0, 1); PG8_STAGE(PG8_SB(0, 0), b2, voffB); PG8_STAGE(PG8_SB(0, 1), b2 + hstep, voffB); PG8_STAGE(PG8_SA(0, 0), a2, voffA);
            PG8_WAIT_V(8); PG8_WAIT_L(0); PG8_BAR; PG8_MMA(1, 0, At, B0); PG8_MMA(1, 1, At, B1); PG8_BAR; PG8_SCHED;
            PG8_LDB(B0, 1, 0); PG8_LDB(B1, 1, 1); PG8_SCHED; PG8_LDA(At, 1, 0); PG8_STAGE(PG8_SA(0, 1), a2 + hstep, voffA);
            PG8_WAIT_V(8); PG8_WAIT_L(0); PG8_BAR; PG8_MMA(0, 0, At, B0); PG8_MMA(0, 1, At, B1); PG8_BAR; PG8_SCHED;
            PG8_LDA(At, 1, 1); PG8_STAGE(PG8_SB(1, 0), b3, voffB); PG8_STAGE(PG8_SB(1, 1), b3 + hstep, voffB); PG8_STAGE(PG8_SA(1, 0), a3, voffA);
            PG8_WAIT_V(8); PG8_WAIT_L(0); PG8_BAR; PG8_MMA(1, 0, At, B0); PG8_MMA(1, 1, At, B1); PG8_BAR; PG8_SCHED;
            } else {
            PG8_LDB(B0, 0, 0); PG8_SCHED; PG8_LDA(At, 0, 0); PG8_STAGE(PG8_SA(1, 1), a1 + hstep, voffA);
            PG8_WAIT_L(8); PG8_BAR; PG8_WAIT_L(0); PG8_MMA(0, 0, At, B0); PG8_BAR; PG8_SCHED;
            PG8_LDB(B1, 0, 1); PG8_STAGE(PG8_SB(0, 0), b2, voffB);
            PG8_BAR; PG8_WAIT_L(0); PG8_MMA(0, 1, At, B1); PG8_BAR;
            PG8_LDA(At, 0, 1); PG8_STAGE(PG8_SA(0, 0), a2, voffA);
            PG8_BAR; PG8_WAIT_L(0); PG8_MMA(1, 0, At, B0); PG8_BAR; PG8_SCHED;
            PG8_STAGE(PG8_SB(0, 1), b2 + hstep, voffB);
            PG8_WAIT_V(6); PG8_BAR; PG8_MMA(1, 1, At, B1); PG8_BAR;
            PG8_LDB(B0, 1, 0); PG8_SCHED; PG8_LDA(At, 1, 0); PG8_STAGE(PG8_SA(0, 1), a2 + hstep, voffA);
            PG8_WAIT_L(8); PG8_BAR; PG8_WAIT_L(0); PG8_MMA(0, 0, At, B0); PG8_BAR; PG8_SCHED;
            PG8_LDB(B1, 1, 1); PG8_STAGE(PG8_SB(1, 0), b3, voffB);
            PG8_BAR; PG8_WAIT_L(0); PG8_MMA(0, 1, At, B1); PG8_BAR;
            PG8_LDA(At, 1, 1); PG8_STAGE(PG8_SA(1, 0), a3, voffA);
            PG8_BAR; PG8_WAIT_L(0); PG8_MMA(1, 0, At, B0); PG8_BAR; PG8_SCHED;
            PG8_STAGE(PG8_SB(1, 1), b3 + hstep, voffB);
            PG8_WAIT_V(6); PG8_BAR; PG8_MMA(1, 1, At, B1); PG8_BAR;
            }
        }
        if constexpr (ALIGN_EPI) { if (wr == 0) PG8_BAR; }
        if constexpr (!Epi::AFTER_DRAIN) { E(acc, cur, wr, wc, fr, fq); S.done(cur); }
        if (!has_next) break;
#pragma unroll
        for (int a = 0; a < 2; ++a)
#pragma unroll
            for (int b = 0; b < 2; ++b)
#pragma unroll
                for (int m = 0; m < 4; ++m)
#pragma unroll
                    for (int n = 0; n < 2; ++n) acc[a][b][m][n] = (f32x4){0.f, 0.f, 0.f, 0.f};
        cur = nxt; cA = nA; cB = nB; ++ui;
        if constexpr (ALIGN_EPI) { if (wr == 1) PG8_BAR; }
    }
    PG8_WAIT_V(0);
    if constexpr (!ALIGN_EPI) { if (wr == 0) PG8_BAR; }
    PG8_BAR;
    if constexpr (Epi::AFTER_DRAIN) { E.fused(acc, cur, wr, wc, fr, fq, lds, wid, lane); S.done(cur); }
#undef PG8_SA
#undef PG8_SB
#undef PG8_STAGE
#undef PG8_LDA
#undef PG8_LDB
#undef PG8_MMA
#undef PG8_WAIT_V
#undef PG8_WAIT_L
#undef PG8_BAR
#undef PG8_SCHED
}
}

constexpr int NB = 2, SEQ = 16384, T = NB * SEQ, D = 1024, CTXL = 256, TC = NB * CTXL, DFF = 2816;
constexpr int NIN0 = 1792, NIN1 = 3072, HD = 64;
constexpr int NWAVES = 8, NTHR = NWAVES * 64;
constexpr float RMS_EPS = 1e-6f, LN_EPS = 1e-5f, LOG2E = 1.4426950408889634f;

constexpr size_t MiB = 1u << 20;
constexpr size_t WS_CTL = 0, CTL_ZERO_BYTES = 65536;
constexpr size_t WS_MOD = 1 * MiB;
constexpr size_t WS_MODC = WS_MOD + 128 * 1024;
constexpr size_t WS_ROPE = WS_MOD + 192 * 1024;
constexpr size_t WS_WIN = 2 * MiB, WS_WOUT = 6 * MiB, WS_W13 = 8 * MiB  , WS_W2 = 30 * MiB  , WS_SCIN = 42 * MiB, WS_SCOUT = 48 * MiB;
constexpr size_t WS_KVC = 50 * MiB;
constexpr size_t WS_WSB = 51 * MiB;
constexpr size_t WS_H = 52 * MiB;
constexpr size_t WS_BIG = 120 * MiB;
constexpr size_t WS_O = 296 * MiB;
constexpr size_t WS_Y = 360 * MiB;
constexpr size_t WS_XB = 424 * MiB;
constexpr size_t WS_END = 488 * MiB;
constexpr int LDS_BYTES = 147456;

#define LAS __attribute__((address_space(3)))
typedef unsigned short bf16;
typedef float f32x4 __attribute__((ext_vector_type(4)));
typedef float f32x16 __attribute__((ext_vector_type(16)));
typedef short bf16x8 __attribute__((ext_vector_type(8)));
typedef short s16x4 __attribute__((ext_vector_type(4)));
typedef unsigned u32x4 __attribute__((ext_vector_type(4)));
typedef unsigned u32x2 __attribute__((ext_vector_type(2)));
using pg8::cvt_pk_bf16;
__device__ __forceinline__ float bf2f(unsigned short v) { return __uint_as_float((unsigned)v << 16); }
__device__ __forceinline__ float bflo(unsigned v) { return __uint_as_float(v << 16); }
__device__ __forceinline__ float bfhi(unsigned v) { return __uint_as_float(v & 0xffff0000u); }
__device__ __forceinline__ float wave_sum(float v) {
#pragma unroll
    for (int o = 1; o < 64; o <<= 1) v += __shfl_xor(v, o);
    return v;
}
typedef short v4i16_t __attribute__((ext_vector_type(4)));
__device__ __forceinline__ s16x4 vtr(const LAS char* p) { return __builtin_bit_cast(s16x4, __builtin_amdgcn_ds_read_tr16_b64_v4i16((LAS v4i16_t*)p)); }
__device__ __forceinline__ int crow(int r, int hi) { return (r & 3) + 8 * (r >> 2) + 4 * hi; }

struct Args {
    const float *x, *c, *ctx, *c_ctx, *w_mod, *b_mod, *g_mix_pre, *g_mix_post, *g_ffn_pre, *g_ffn_post, *ffn_w1, *ffn_w3, *ffn_w2, *a_w_in, *a_sink, *gm_v_norm, *gm_ws, *gm_bs, *a_w_out, *sc_w_in, *sc_conv, *sc_w_out;
    float* out; unsigned char* ws; int ph_lo, ph_hi;
};


#define XB_TMO      128
#define XB_XCNT(j)  (256  + 64 * (j))
#define XB_XSUB(j)  (1280 + 64 * (j))
#define XB_XGEN(j)  (2304 + 64 * (j))
#define XB_TOP      3328
#define XB_TOPGEN   3392
#define XCD_BAR_WORDS 3456
#define XB_SPIN_CAP (1u << 18)

__device__ __forceinline__ unsigned xb_ld(unsigned* p)              { return __hip_atomic_load(p, __ATOMIC_RELAXED, __HIP_MEMORY_SCOPE_AGENT); }
__device__ __forceinline__ unsigned xb_add(unsigned* p, unsigned v) { return __hip_atomic_fetch_add(p, v, __ATOMIC_RELAXED, __HIP_MEMORY_SCOPE_AGENT); }
__device__ __forceinline__ unsigned xb_xcc_id() { return (unsigned)__builtin_amdgcn_s_getreg((3 << 11) | 20) & 0xFu; }
#define XB_SPIN(cond, bar) do { unsigned _sp = 0; while (cond) { __builtin_amdgcn_s_sleep(0); \
    if ((++_sp & 255u) == 0u) { if (xb_ld(&(bar)[XB_TMO])) break; if (_sp > XB_SPIN_CAP) { atomicAdd(&(bar)[XB_TMO], 1u); break; } } } } while (0)

struct XcdBarrier {
    unsigned* bar; unsigned x;
    volatile LAS unsigned* st;
};

__device__ __forceinline__ XcdBarrier xcd_barrier_post(unsigned* bar, volatile LAS unsigned* st) {
    XcdBarrier b; b.bar = bar; b.x = xb_xcc_id(); b.st = st;
    if (threadIdx.x == 0) st[2] = xb_add(&bar[XB_XCNT(b.x)], 1u);
    return b;
}
__device__ __forceinline__ void xcd_barrier_complete(unsigned* bar, unsigned x, unsigned& nloc, unsigned& nx) {
    const unsigned G = gridDim.x * gridDim.y * gridDim.z;
    unsigned sum, cnt, mine, sp = 0u;
    for (;;) {
        sum = 0u; cnt = 0u; mine = 0u;
#pragma unroll
        for (unsigned j = 0; j < 16; ++j) { const unsigned c = xb_ld(&bar[XB_XCNT(j)]); sum += c; cnt += (c > 0u) ? 1u : 0u; mine = (j == x) ? c : mine; }
        if (sum == G) break;
        __builtin_amdgcn_s_sleep(1);
        if ((++sp & 255u) == 0u) { if (xb_ld(&bar[XB_TMO])) break; if (sp > XB_SPIN_CAP) { atomicAdd(&bar[XB_TMO], 1u); break; } }
    }
    nloc = mine > 0u ? mine : 1u; nx = cnt > 0u ? cnt : 1u;
}

__device__ __forceinline__ void xcd_barrier(const XcdBarrier& b) {
    asm volatile("s_waitcnt vmcnt(0)" ::: "memory");
    __syncthreads();
    if (threadIdx.x == 0) {
        unsigned* bar = b.bar;
        __builtin_amdgcn_s_waitcnt(0);
        unsigned nloc = b.st[0], nx = b.st[1];
        if (nloc == 0u) { xcd_barrier_complete(bar, b.x, nloc, nx); b.st[0] = nloc; b.st[1] = nx; }
        const unsigned old = xb_add(&bar[XB_XSUB(b.x)], 1u);
        const unsigned gen = old / nloc;
        if (old + 1u == (gen + 1u) * nloc) {
            __builtin_amdgcn_fence(__ATOMIC_RELEASE, "agent");
            asm volatile("s_waitcnt vmcnt(0)" ::: "memory");
            const unsigned og = xb_add(&bar[XB_TOP], 1u);
            const unsigned tg = og / nx;
            if (og + 1u == (tg + 1u) * nx) xb_add(&bar[XB_TOPGEN], 1u);
            else XB_SPIN(xb_ld(&bar[XB_TOPGEN]) == tg, bar);
            __builtin_amdgcn_fence(__ATOMIC_ACQUIRE, "agent");
            xb_add(&bar[XB_XGEN(b.x)], 1u);
            asm volatile("s_waitcnt vmcnt(0)" ::: "memory");
        } else {
            XB_SPIN(xb_ld(&bar[XB_XGEN(b.x)]) == gen, bar);
            __builtin_amdgcn_fence(__ATOMIC_ACQUIRE, "agent");
            asm volatile("s_waitcnt vmcnt(0)" ::: "memory");
        }
    }
    __syncthreads();
}

#define XH_TOP(h)     (5504 + 128 * (h))
#define XH_TOPGEN(h)  (5568 + 128 * (h))
#define XW_FLAG       5760
__device__ __forceinline__ void xcd_half_barrier(const XcdBarrier& b, unsigned h) {
    asm volatile("s_waitcnt vmcnt(0)" ::: "memory");
    __syncthreads();
    if (threadIdx.x == 0) {
        unsigned* bar = b.bar;
        __builtin_amdgcn_s_waitcnt(0);
        const unsigned nloc = b.st[0], nx = 4u;
        const unsigned old = xb_add(&bar[XB_XSUB(b.x)], 1u);
        const unsigned gen = old / nloc;
        if (old + 1u == (gen + 1u) * nloc) {
            __builtin_amdgcn_fence(__ATOMIC_RELEASE, "agent");
            asm volatile("s_waitcnt vmcnt(0)" ::: "memory");
            const unsigned og = xb_add(&bar[XH_TOP(h)], 1u);
            const unsigned tg = og / nx;
            if (og + 1u == (tg + 1u) * nx) xb_add(&bar[XH_TOPGEN(h)], 1u);
            else XB_SPIN(xb_ld(&bar[XH_TOPGEN(h)]) == tg, bar);
            __builtin_amdgcn_fence(__ATOMIC_ACQUIRE, "agent");
            xb_add(&bar[XB_XGEN(b.x)], 1u);
            asm volatile("s_waitcnt vmcnt(0)" ::: "memory");
        } else {
            XB_SPIN(xb_ld(&bar[XB_XGEN(b.x)]) == gen, bar);
            __builtin_amdgcn_fence(__ATOMIC_ACQUIRE, "agent");
            asm volatile("s_waitcnt vmcnt(0)" ::: "memory");
        }
    }
    __syncthreads();
}

#define XL_SUB(j)  (3456 + 64 * (j))
#define XL_GEN(j)  (4480 + 64 * (j))
#define XL_WORDS   5888
__device__ __forceinline__ void xcd_local_barrier(const XcdBarrier& b) {
    asm volatile("s_waitcnt vmcnt(0)" ::: "memory");
    __syncthreads();
    if (threadIdx.x == 0) {
        unsigned* bar = b.bar;
        __builtin_amdgcn_s_waitcnt(0);
        const unsigned nloc = b.st[0];
        const unsigned old = xb_add(&bar[XL_SUB(b.x)], 1u);
        const unsigned gen = old / nloc;
        if (old + 1u == (gen + 1u) * nloc) xb_add(&bar[XL_GEN(b.x)], 1u);
        else XB_SPIN(xb_ld(&bar[XL_GEN(b.x)]) == gen, bar);
        __builtin_amdgcn_fence(__ATOMIC_ACQUIRE, "agent");
        asm volatile("s_waitcnt vmcnt(0)" ::: "memory");
    }
    __syncthreads();
}

__device__ __forceinline__ void p0_transpose_item(const float* W, int K, int N, bf16* WT, int mode, LAS float* scr, int item, int lane) {
    const int nblk = N / 32, kb = item / nblk, nb = item % nblk, k0 = 64 * kb, n0 = 32 * nb;
    int drow0 = n0;
    if (mode == 1) drow0 = (n0 >> 7) * 256 + (n0 & 127);
    else if (mode == 2) drow0 = (n0 >> 7) * 256 + 128 + (n0 & 127);
    else if (mode == 3) {
        if (n0 < 1024) drow0 = 2048 + n0;
        else if (n0 < 2048) { const int j = n0 - 1024; drow0 = (j >> 7) * 256 + (j & 127); }
        else { const int j = n0 - 2048; drow0 = (j >> 7) * 256 + 128 + (j & 127); }
    }
#pragma unroll 8
    for (int i = 0; i < 32; ++i) { const int kk = 2 * i + (lane >> 5); scr[kk * 33 + (lane & 31)] = __builtin_nontemporal_load(W + (size_t)(k0 + kk) * N + n0 + (lane & 31)); }
    asm volatile("s_waitcnt lgkmcnt(0)" ::: "memory");
    const int c = lane & 7;
#pragma unroll
    for (int j = 0; j < 4; ++j) { const int n = (lane >> 3) + 8 * j; const LAS float* s = scr + (8 * c) * 33 + n;
        u32x4 o; o.x = cvt_pk_bf16(s[0 * 33], s[1 * 33]); o.y = cvt_pk_bf16(s[2 * 33], s[3 * 33]); o.z = cvt_pk_bf16(s[4 * 33], s[5 * 33]); o.w = cvt_pk_bf16(s[6 * 33], s[7 * 33]);
        *(u32x4*)(WT + (size_t)(drow0 + n) * K + k0 + 8 * c) = o; }
    asm volatile("s_waitcnt lgkmcnt(0)" ::: "memory");
}


constexpr int I_IN = 16 * 56, I_OUT = 16 * 32, I_W1 = 16 * 88, I_W2 = 44 * 32, I_SCI = 16 * 96, I_SCO = 16 * 32;
constexpr int NT_ITEMS = I_IN + I_OUT + 4 * I_W1 + 2 * I_W2 + I_SCI + I_SCO, NP0_ITEMS = I_IN + I_OUT;
__device__ __forceinline__ void transpose_dispatch(const Args& a, int it, LAS float* scr, int lane) {
    unsigned char* ws = a.ws; int r = it;
    if (r < I_IN) { p0_transpose_item(a.a_w_in, 1024, NIN0, (bf16*)(ws + WS_WIN), 0, scr, r, lane); return; } r -= I_IN;
    if (r < I_OUT) { p0_transpose_item(a.a_w_out, 1024, 1024, (bf16*)(ws + WS_WOUT), 0, scr, r, lane); return; } r -= I_OUT;
    if (r < 4 * I_W1) { const int q = r / I_W1, layer = q >> 1, which = q & 1; r -= q * I_W1;
        p0_transpose_item((which ? a.ffn_w3 : a.ffn_w1) + (size_t)layer * 1024 * DFF, 1024, DFF, (bf16*)(ws + WS_W13 + layer * 11 * MiB), 1 + which, scr, r, lane); return; } r -= 4 * I_W1;
    if (r < 2 * I_W2) { const int layer = r / I_W2; r -= layer * I_W2;
        p0_transpose_item(a.ffn_w2 + (size_t)layer * DFF * 1024, DFF, 1024, (bf16*)(ws + WS_W2 + layer * 6 * MiB), 0, scr, r, lane); return; } r -= 2 * I_W2;
    if (r < I_SCI) { p0_transpose_item(a.sc_w_in, 1024, NIN1, (bf16*)(ws + WS_SCIN), 3, scr, r, lane); return; } r -= I_SCI;
    p0_transpose_item(a.sc_w_out, 1024, 1024, (bf16*)(ws + WS_SCOUT), 0, scr, r, lane);
}

__device__ __forceinline__ float silu_f(float v) { return v / (1.0f + __expf(-v)); }

__device__ __forceinline__ void p0_prologue(const Args& a, LAS unsigned char* lds, int G) {
    const int tid = threadIdx.x, lane = tid & 63, wid = __builtin_amdgcn_readfirstlane(tid >> 6);
    unsigned char* ws = a.ws;
    float* mod = (float*)(ws + WS_MOD); float* modc = (float*)(ws + WS_MODC); float* rope = (float*)(ws + WS_ROPE);
    for (int e = blockIdx.x * NTHR + tid; e < 256 * 16; e += G * NTHR) {
        const int pos = e >> 4, i = e & 15;
        const float inv = exp2f(-(float)i * (13.287712379549449f / 16.0f));
        const float ang = (float)pos * inv;
        const double rev = (double)ang * 0.15915494309189533577;
        const float fr = (float)(rev - floor(rev));
        rope[2 * e] = __builtin_amdgcn_cosf(fr); rope[2 * e + 1] = __builtin_amdgcn_sinf(fr);
    }
    for (int e = blockIdx.x * NTHR + tid; e < 8 * 128 * 128 / 8; e += G * NTHR) {
        const f32x4 v0 = *(const f32x4*)(a.gm_ws + (size_t)e * 8), v1 = *(const f32x4*)(a.gm_ws + (size_t)e * 8 + 4);
        u32x4 w; w.x = cvt_pk_bf16(v0[0], v0[1]); w.y = cvt_pk_bf16(v0[2], v0[3]); w.z = cvt_pk_bf16(v1[0], v1[1]); w.w = cvt_pk_bf16(v1[2], v1[3]);
        *(u32x4*)((bf16*)(ws + WS_WSB) + (size_t)e * 8) = w;
    }
    LAS float* sv = (LAS float*)lds;
    LAS float* red = (LAS float*)(lds + 12288);
    bool have_silu = false;
    for (int it = blockIdx.x; it < 48; it += G) {
        if (!have_silu) {
            for (int k = tid; k < 1024; k += NTHR) { sv[k] = silu_f(a.c[k]); sv[1024 + k] = silu_f(a.c[1024 + k]); sv[2048 + k] = silu_f(a.c_ctx[k]); }
            have_silu = true;
        }
        __syncthreads();
        const int layer = it / 24, cgp = it % 24, c0 = cgp * 256;
        const float* W = a.w_mod + (size_t)layer * 1024 * 6144 + c0 + 4 * lane;
        f32x4 a0 = {0, 0, 0, 0}, a1 = {0, 0, 0, 0}, a2 = {0, 0, 0, 0};
        const int kb = wid * 128;
#pragma unroll 8
        for (int k = 0; k < 128; ++k) {
            const f32x4 w = __builtin_nontemporal_load((const f32x4*)(W + (size_t)(kb + k) * 6144));
            const float s0 = sv[kb + k], s1 = sv[1024 + kb + k], s2 = sv[2048 + kb + k];
            a0 += w * s0; a1 += w * s1; a2 += w * s2;
        }
        *(LAS f32x4*)(red + (wid * 3 + 0) * 256 + 4 * lane) = a0;
        *(LAS f32x4*)(red + (wid * 3 + 1) * 256 + 4 * lane) = a1;
        *(LAS f32x4*)(red + (wid * 3 + 2) * 256 + 4 * lane) = a2;
        __syncthreads();
        if (tid < 256) {
            float r0 = 0.f, r1 = 0.f, r2 = 0.f;
#pragma unroll
            for (int w = 0; w < 8; ++w) { r0 += red[(w * 3 + 0) * 256 + tid]; r1 += red[(w * 3 + 1) * 256 + tid]; r2 += red[(w * 3 + 2) * 256 + tid]; }
            const float bias = a.b_mod[layer * 6144 + c0 + tid];
            mod[(layer * 2 + 0) * 6144 + c0 + tid] = r0 + bias;
            mod[(layer * 2 + 1) * 6144 + c0 + tid] = r1 + bias;
            if (layer == 0 && c0 < 2048) modc[c0 + tid] = r2 + bias;
        }
    }
    __syncthreads();
    LAS float* scr = (LAS float*)(lds + wid * 16384);
    const int gw = blockIdx.x * NWAVES + wid, NGW = G * NWAVES;
    for (int it = gw; it < NP0_ITEMS; it += NGW) transpose_dispatch(a, it, scr, lane);
}
__device__ __forceinline__ void late_transposes(const Args& a, LAS unsigned char* lds, int worker, int nworkers) {
    const int lane = threadIdx.x & 63, wid = __builtin_amdgcn_readfirstlane(threadIdx.x >> 6);
    LAS float* scr = (LAS float*)(lds + wid * 16384);
    for (int it = NP0_ITEMS + worker; it < NT_ITEMS; it += nworkers) transpose_dispatch(a, it, scr, lane);
}

template <bool XIN16, bool XOUT16>
__device__ __forceinline__ void rowpass(const void* xin_, const bf16* Y, void* xout_, bf16* H, const float* gpost, const float* gate, const float* gpre, const float* sc, const float* sh,
                                        int mod_stride, int nrows, int rows_per_batch, int G, int blk) {
    const int tid = threadIdx.x, lane = tid & 63, wid = __builtin_amdgcn_readfirstlane(tid >> 6);
    const int NGW = G * NWAVES;
    const int vb = (G % 8 == 0) ? (blk % 8) * (G / 8) + (blk / 8) : blk;
    const int gw = vb * NWAVES + wid;
    const int rpw = (nrows + NGW - 1) / NGW;
    const int r0 = gw * rpw, r1 = (r0 + rpw < nrows) ? r0 + rpw : nrows;
    f32x4 A1[4], A2[4], A3[4];
    int curb = -1;
    for (int r = r0; r < r1; ++r) {
        const int b = r / rows_per_batch;
        if (b != curb) { curb = b;
#pragma unroll
            for (int j = 0; j < 4; ++j) { const int cidx = 4 * lane + 256 * j;
                if (Y) { A1[j] = *(const f32x4*)(gate + (size_t)b * mod_stride + cidx) * *(const f32x4*)(gpost + cidx); }
                if (H) { A2[j] = *(const f32x4*)(gpre + cidx) * (*(const f32x4*)(sc + (size_t)b * mod_stride + cidx) + 1.0f); A3[j] = *(const f32x4*)(sh + (size_t)b * mod_stride + cidx); }
            }
        }
        f32x4 xv[4];
        if (XIN16) {
#pragma unroll
            for (int j = 0; j < 4; ++j) { const u32x2 w = __builtin_nontemporal_load((const u32x2*)((const bf16*)xin_ + (size_t)r * D + 4 * lane + 256 * j)); xv[j] = (f32x4){bflo(w.x), bfhi(w.x), bflo(w.y), bfhi(w.y)}; }
        } else {
#pragma unroll
            for (int j = 0; j < 4; ++j) xv[j] = __builtin_nontemporal_load((const f32x4*)((const float*)xin_ + (size_t)r * D + 4 * lane + 256 * j));
        }
        if (Y) {
            f32x4 yv[4]; float s = 0.f;
#pragma unroll
            for (int j = 0; j < 4; ++j) { const u32x2 w = __builtin_nontemporal_load((const u32x2*)(Y + (size_t)r * D + 4 * lane + 256 * j));
                yv[j] = (f32x4){bflo(w.x), bfhi(w.x), bflo(w.y), bfhi(w.y)}; s += (yv[j][0] * yv[j][0] + yv[j][1] * yv[j][1]) + (yv[j][2] * yv[j][2] + yv[j][3] * yv[j][3]); }
            const float ry = 1.0f / sqrtf(wave_sum(s) * (1.0f / D) + RMS_EPS);
#pragma unroll
            for (int j = 0; j < 4; ++j) xv[j] = xv[j] + A1[j] * (yv[j] * ry);
        }
        if (xout_) {
            if (XOUT16) {
#pragma unroll
                for (int j = 0; j < 4; ++j) { u32x2 w; w.x = cvt_pk_bf16(xv[j][0], xv[j][1]); w.y = cvt_pk_bf16(xv[j][2], xv[j][3]); __builtin_nontemporal_store(w, (u32x2*)((bf16*)xout_ + (size_t)r * D + 4 * lane + 256 * j)); }
            } else {
#pragma unroll
                for (int j = 0; j < 4; ++j) __builtin_nontemporal_store(xv[j], (f32x4*)((float*)xout_ + (size_t)r * D + 4 * lane + 256 * j));
            }
        }
        if (H) {
            float s = 0.f;
#pragma unroll
            for (int j = 0; j < 4; ++j) s += (xv[j][0] * xv[j][0] + xv[j][1] * xv[j][1]) + (xv[j][2] * xv[j][2] + xv[j][3] * xv[j][3]);
            const float rx = 1.0f / sqrtf(wave_sum(s) * (1.0f / D) + RMS_EPS);
#pragma unroll
            for (int j = 0; j < 4; ++j) { const f32x4 h = (xv[j] * rx) * A2[j] + A3[j]; u32x2 w; w.x = cvt_pk_bf16(h[0], h[1]); w.y = cvt_pk_bf16(h[2], h[3]);
                *(u32x2*)(H + (size_t)r * D + 4 * lane + 256 * j) = w; }
        }
    }
}

__device__ __forceinline__ void attn_unit(LAS unsigned char* lds, const bf16* QKV, const bf16* KVC, bf16* O, const float* sink, int unit) {
    const int tid = threadIdx.x, lane = tid & 63, wid = __builtin_amdgcn_readfirstlane(tid >> 6), r32 = lane & 31, hi = lane >> 5;
    const int kvh = unit & 1, nb = (unit >> 1) & 127, b = unit >> 8;
    const int g = wid >> 1, th = wid & 1, h = kvh * 4 + g;
    const size_t t0 = (size_t)b * SEQ + (size_t)nb * 128;
    bf16x8 qf[2][4];
#pragma unroll
    for (int qg = 0; qg < 2; ++qg)
#pragma unroll
        for (int ks = 0; ks < 4; ++ks) qf[qg][ks] = *(const bf16x8*)(QKV + (t0 + th * 64 + qg * 32 + r32) * NIN0 + h * 64 + ks * 16 + hi * 8);
    LAS unsigned char* qlds = lds + 32768 + wid * 8192 + lane * 16;
#pragma unroll
    for (int qg = 0; qg < 2; ++qg)
#pragma unroll
        for (int ks = 0; ks < 4; ++ks) *(LAS bf16x8*)(qlds + (qg * 4 + ks) * 1024) = qf[qg][ks];
    float mrun[2], lrun[2]; f32x16 o[2][2];
    const float sk = sink[h] * LOG2E;
#pragma unroll
    for (int qg = 0; qg < 2; ++qg) { mrun[qg] = sk; lrun[qg] = hi ? 0.f : 1.f;
#pragma unroll
        for (int dg = 0; dg < 2; ++dg)
#pragma unroll
            for (int r = 0; r < 16; ++r) o[dg][qg][r] = 0.f; }
    const int lkey = tid >> 3, lch = tid & 7;
    const unsigned kw_off = (unsigned)(lkey * 128 + ((lch ^ (lkey & 7)) << 4));
    const unsigned vw_off = (unsigned)(8192 + (lch >> 2) * 4096 + lkey * 64 + (lch & 3) * 16);
    u32x4 kreg, vreg;
#define LOAD_TILE(tl_) do { const int tl__ = (tl_); \
        if (tl__ < 6) { \
            const int kpos = (nb - 1) * 128 + tl__ * 64 + lkey; \
            if (kpos >= 0 && kpos < SEQ) { const bf16* p = QKV + ((size_t)b * SEQ + kpos) * NIN0 + 512 + kvh * 64 + lch * 8; kreg = *(const u32x4*)p; vreg = *(const u32x4*)(p + 128); } \
            else { kreg = (u32x4){0, 0, 0, 0}; vreg = (u32x4){0, 0, 0, 0}; } \
        } else { \
            const bf16* p = KVC + ((size_t)b * CTXL + (tl__ - 6) * 64 + lkey) * 256 + kvh * 64 + lch * 8; kreg = *(const u32x4*)p; vreg = *(const u32x4*)(p + 128); \
        } } while (0)
    LOAD_TILE(0);
    const unsigned kr_base = (unsigned)(r32 * 128);
    const unsigned vr_base = (unsigned)(8192 + (4 * hi + ((lane & 15) >> 2)) * 64 + ((lane >> 4) & 1) * 32 + (lane & 3) * 8);
    for (int tl = 0; tl < 10; ++tl) {
        LAS unsigned char* buf = lds + (tl & 1) * 16384;
        *(LAS u32x4*)(buf + kw_off) = kreg; *(LAS u32x4*)(buf + vw_off) = vreg;
        if (tl + 1 < 10) LOAD_TILE(tl + 1);
        __syncthreads();
        int cls = 1;
        if (tl < 6) { const int kpos0 = (nb - 1) * 128 + tl * 64;
            if (kpos0 < 0 || kpos0 >= SEQ || tl < th || tl > th + 4) cls = 0; else cls = (tl == th || tl == th + 4) ? 2 : 1; }
        if (cls != 0) {
        f32x16 sacc[2][2];
#pragma unroll
        for (int kg = 0; kg < 2; ++kg)
#pragma unroll
            for (int qg = 0; qg < 2; ++qg)
#pragma unroll
                for (int r = 0; r < 16; ++r) sacc[kg][qg][r] = -mrun[qg];
#pragma unroll
        for (int kg = 0; kg < 2; ++kg)
#pragma unroll
            for (int ks = 0; ks < 4; ++ks) {
                const bf16x8 kf = *(const LAS bf16x8*)(buf + kr_base + kg * 4096 + ((((ks * 2 + hi) ^ (r32 & 7))) << 4));
#pragma unroll
                for (int qg = 0; qg < 2; ++qg) { const bf16x8 qv = *(const LAS bf16x8*)(qlds + (qg * 4 + ks) * 1024);
                    sacc[kg][qg] = __builtin_amdgcn_mfma_f32_32x32x16_bf16(kf, qv, sacc[kg][qg], 0, 0, 0); }
            }
        bf16x8 pf[2][2][2];
#pragma unroll
        for (int qg = 0; qg < 2; ++qg) {
            if (cls == 2) {
                const int qi = th * 64 + qg * 32 + r32;
#pragma unroll
                for (int kg = 0; kg < 2; ++kg)
#pragma unroll
                    for (int r = 0; r < 16; ++r) { const int kj = tl * 64 + kg * 32 + crow(r, hi);
                        const bool valid = (kj >= qi) && (kj <= qi + 256); sacc[kg][qg][r] = valid ? sacc[kg][qg][r] : -1.0e30f; }
            }
            float mxa = fmaxf(sacc[0][qg][0], sacc[1][qg][0]), mxb = fmaxf(sacc[0][qg][1], sacc[1][qg][1]);
#pragma unroll
            for (int r = 2; r < 16; r += 2) { mxa = fmaxf(fmaxf(mxa, sacc[0][qg][r]), sacc[1][qg][r]); mxb = fmaxf(fmaxf(mxb, sacc[0][qg][r + 1]), sacc[1][qg][r + 1]); }
            float mx = fmaxf(mxa, mxb);
            mx = fmaxf(mx, __shfl_xor(mx, 32));
            if (__any(mx > 0.f)) {
                const float dl = fmaxf(mx, 0.f); mrun[qg] += dl;
                const float alpha = __builtin_amdgcn_exp2f(-dl); lrun[qg] *= alpha;
#pragma unroll
                for (int kg = 0; kg < 2; ++kg)
#pragma unroll
                    for (int r = 0; r < 16; ++r) sacc[kg][qg][r] -= dl;
#pragma unroll
                for (int dg = 0; dg < 2; ++dg)
#pragma unroll
                    for (int r = 0; r < 16; ++r) o[dg][qg][r] *= alpha;
            }
            float psa = 0.f, psb = 0.f;
#pragma unroll
            for (int kg = 0; kg < 2; ++kg)
#pragma unroll
                for (int r = 0; r < 16; r += 2) { const float p0 = __builtin_amdgcn_exp2f(sacc[kg][qg][r]), p1 = __builtin_amdgcn_exp2f(sacc[kg][qg][r + 1]); sacc[kg][qg][r] = p0; sacc[kg][qg][r + 1] = p1; psa += p0; psb += p1; }
            lrun[qg] += psa + psb;
#pragma unroll
            for (int kg = 0; kg < 2; ++kg)
#pragma unroll
                for (int s = 0; s < 2; ++s) { u32x4 w;
                    w.x = cvt_pk_bf16(sacc[kg][qg][8 * s + 0], sacc[kg][qg][8 * s + 1]); w.y = cvt_pk_bf16(sacc[kg][qg][8 * s + 2], sacc[kg][qg][8 * s + 3]);
                    w.z = cvt_pk_bf16(sacc[kg][qg][8 * s + 4], sacc[kg][qg][8 * s + 5]); w.w = cvt_pk_bf16(sacc[kg][qg][8 * s + 6], sacc[kg][qg][8 * s + 7]);
                    pf[kg][qg][s] = __builtin_bit_cast(bf16x8, w); }
        }
#pragma unroll
        for (int dg = 0; dg < 2; ++dg)
#pragma unroll
            for (int kg = 0; kg < 2; ++kg)
#pragma unroll
                for (int s = 0; s < 2; ++s) {
                    const LAS char* vp = (const LAS char*)(buf + vr_base + dg * 4096 + (kg * 32 + 16 * s) * 64);
                    const s16x4 lo = vtr(vp), hi4 = vtr(vp + 512);
                    const bf16x8 vf = (bf16x8){lo[0], lo[1], lo[2], lo[3], hi4[0], hi4[1], hi4[2], hi4[3]};
#pragma unroll
                    for (int qg = 0; qg < 2; ++qg) o[dg][qg] = __builtin_amdgcn_mfma_f32_32x32x16_bf16(vf, pf[kg][qg][s], o[dg][qg], 0, 0, 0);
                }
        }
    }
#pragma unroll
    for (int qg = 0; qg < 2; ++qg) {
        const float lt = lrun[qg] + __shfl_xor(lrun[qg], 32); const float inv = 1.0f / lt;
        bf16* op = O + (t0 + th * 64 + qg * 32 + r32) * D + h * 64 + 4 * hi;
#pragma unroll
        for (int dg = 0; dg < 2; ++dg)
#pragma unroll
            for (int rg = 0; rg < 4; ++rg) { u32x2 w; w.x = cvt_pk_bf16(o[dg][qg][4 * rg] * inv, o[dg][qg][4 * rg + 1] * inv); w.y = cvt_pk_bf16(o[dg][qg][4 * rg + 2] * inv, o[dg][qg][4 * rg + 3] * inv);
                *(u32x2*)(op + dg * 32 + 8 * rg) = w; }
    }
    __syncthreads();
}

__device__ __forceinline__ void gate_unit(LAS unsigned char* lds, const bf16* QKV, bf16* O, const float* vnorm, const bf16* wsg, const float* bsg, int unit) {
    const int tid = threadIdx.x, lane = tid & 63, wid = __builtin_amdgcn_readfirstlane(tid >> 6), r32 = lane & 31, hi = lane >> 5;
    const int g = wid; const size_t t0 = (size_t)unit * 128;
    LAS unsigned char* img = lds + wid * 16384;
    {
        const int d8 = lane & 7;
        const f32x4 n0 = *(const f32x4*)(vnorm + g * 64 + d8 * 8), n1 = *(const f32x4*)(vnorm + g * 64 + d8 * 8 + 4);
#pragma unroll 8
        for (int it = 0; it < 16; ++it) {
            const int j = it * 8 + (lane >> 3);
            const u32x4 w = *(const u32x4*)(QKV + (t0 + j) * NIN0 + 1280 + g * 64 + d8 * 8);
            float v[8] = {bflo(w.x), bfhi(w.x), bflo(w.y), bfhi(w.y), bflo(w.z), bfhi(w.z), bflo(w.w), bfhi(w.w)};
            float s = ((v[0] + v[1]) + (v[2] + v[3])) + ((v[4] + v[5]) + (v[6] + v[7]));
            s += __shfl_xor(s, 1); s += __shfl_xor(s, 2); s += __shfl_xor(s, 4);
            const float mu = s * (1.0f / 64.0f); float q = 0.f;
#pragma unroll
            for (int e = 0; e < 8; ++e) { v[e] -= mu; q += v[e] * v[e]; }
            q += __shfl_xor(q, 1); q += __shfl_xor(q, 2); q += __shfl_xor(q, 4);
            const float rs = 1.0f / sqrtf(q * (1.0f / 64.0f) + LN_EPS);
            u32x4 ow; ow.x = cvt_pk_bf16(v[0] * rs * n0[0], v[1] * rs * n0[1]); ow.y = cvt_pk_bf16(v[2] * rs * n0[2], v[3] * rs * n0[3]);
            ow.z = cvt_pk_bf16(v[4] * rs * n1[0], v[5] * rs * n1[1]); ow.w = cvt_pk_bf16(v[6] * rs * n1[2], v[7] * rs * n1[3]);
            *(LAS u32x4*)(img + (d8 >> 2) * 8192 + j * 64 + (d8 & 3) * 16) = ow;
        }
    }
    __syncthreads();
    const unsigned vr_base = (unsigned)((8 * hi + ((lane & 15) >> 2)) * 64 + ((lane >> 4) & 1) * 32 + (lane & 3) * 8);
    const bf16* wsp = wsg + (size_t)g * 128 * 128;
    bf16x8 vf[2][8];
#pragma unroll
    for (int dg = 0; dg < 2; ++dg)
#pragma unroll
        for (int ks = 0; ks < 8; ++ks) {
            const LAS char* vp = (const LAS char*)(img + vr_base + dg * 8192 + (16 * ks) * 64);
            const s16x4 lo = vtr(vp), hi4 = vtr(vp + 256);
            vf[dg][ks] = (bf16x8){lo[0], lo[1], lo[2], lo[3], hi4[0], hi4[1], hi4[2], hi4[3]};
        }
#pragma unroll 1
    for (int ig = 0; ig < 4; ++ig) {
        const int i = ig * 32 + r32;
        bf16x8 wf[8];
#pragma unroll
        for (int ks = 0; ks < 8; ++ks) wf[ks] = *(const bf16x8*)(wsp + (size_t)i * 128 + ks * 16 + hi * 8);
        const float bias = bsg[g * 128 + i];
        const bf16* up = QKV + (t0 + i) * NIN0 + 768 + g * 64 + 4 * hi;
        u32x2 uw[2][4];
#pragma unroll
        for (int dg = 0; dg < 2; ++dg)
#pragma unroll
            for (int rg = 0; rg < 4; ++rg) uw[dg][rg] = *(const u32x2*)(up + dg * 32 + 8 * rg);
        f32x16 acc0, acc1;
#pragma unroll
        for (int r = 0; r < 16; ++r) { acc0[r] = 0.f; acc1[r] = 0.f; }
#pragma unroll
        for (int ks = 0; ks < 8; ++ks) {
            acc0 = __builtin_amdgcn_mfma_f32_32x32x16_bf16(vf[0][ks], wf[ks], acc0, 0, 0, 0);
            acc1 = __builtin_amdgcn_mfma_f32_32x32x16_bf16(vf[1][ks], wf[ks], acc1, 0, 0, 0);
        }
        bf16* op = O + (t0 + i) * D + 512 + g * 64 + 4 * hi;
#pragma unroll
        for (int rg = 0; rg < 4; ++rg) {
            u32x2 w; w.x = cvt_pk_bf16(bflo(uw[0][rg].x) * (acc0[4 * rg] + bias), bfhi(uw[0][rg].x) * (acc0[4 * rg + 1] + bias)); w.y = cvt_pk_bf16(bflo(uw[0][rg].y) * (acc0[4 * rg + 2] + bias), bfhi(uw[0][rg].y) * (acc0[4 * rg + 3] + bias));
            *(u32x2*)(op + 8 * rg) = w;
            u32x2 w1; w1.x = cvt_pk_bf16(bflo(uw[1][rg].x) * (acc1[4 * rg] + bias), bfhi(uw[1][rg].x) * (acc1[4 * rg + 1] + bias)); w1.y = cvt_pk_bf16(bflo(uw[1][rg].y) * (acc1[4 * rg + 2] + bias), bfhi(uw[1][rg].y) * (acc1[4 * rg + 3] + bias));
            *(u32x2*)(op + 32 + 8 * rg) = w1;
        }
    }
    __syncthreads();
}

struct ConvIn { u32x4 y0, y1, y2, bg; };
__device__ __forceinline__ ConvIn conv_load(const bf16* __restrict__ Y1, const bf16* __restrict__ BG, int it) {
    const int t = it >> 7, c = (it & 127) * 8; const int s = t & (SEQ - 1); ConvIn v;
    v.y1 = *(const u32x4*)(Y1 + (size_t)t * D + c);
    v.y0 = (s > 0) ? *(const u32x4*)(Y1 + (size_t)(t - 1) * D + c) : (u32x4){0, 0, 0, 0};
    v.y2 = (s < SEQ - 1) ? *(const u32x4*)(Y1 + (size_t)(t + 1) * D + c) : (u32x4){0, 0, 0, 0};
    v.bg = *(const u32x4*)(BG + (size_t)t * D + c);
    return v;
}
__device__ __forceinline__ void conv_store(bf16* __restrict__ Z, const float* __restrict__ cw, int it, const ConvIn& v) {
    const int t = it >> 7, c = (it & 127) * 8;
    const f32x4 w0a = *(const f32x4*)(cw + c), w0b = *(const f32x4*)(cw + c + 4), w1a = *(const f32x4*)(cw + D + c), w1b = *(const f32x4*)(cw + D + c + 4), w2a = *(const f32x4*)(cw + 2 * D + c), w2b = *(const f32x4*)(cw + 2 * D + c + 4);
    float r[8];
#pragma unroll
    for (int e = 0; e < 4; ++e) {
        const unsigned a0 = v.y0[e], a1 = v.y1[e], a2 = v.y2[e], gb = v.bg[e];
        const float wl0 = (e < 2) ? w0a[2 * e] : w0b[2 * e - 4], wh0 = (e < 2) ? w0a[2 * e + 1] : w0b[2 * e - 3];
        const float wl1 = (e < 2) ? w1a[2 * e] : w1b[2 * e - 4], wh1 = (e < 2) ? w1a[2 * e + 1] : w1b[2 * e - 3];
        const float wl2 = (e < 2) ? w2a[2 * e] : w2b[2 * e - 4], wh2 = (e < 2) ? w2a[2 * e + 1] : w2b[2 * e - 3];
        r[2 * e] = bflo(gb) * (wl0 * bflo(a0) + wl1 * bflo(a1) + wl2 * bflo(a2));
        r[2 * e + 1] = bfhi(gb) * (wh0 * bfhi(a0) + wh1 * bfhi(a1) + wh2 * bfhi(a2));
    }
    u32x4 w; w.x = cvt_pk_bf16(r[0], r[1]); w.y = cvt_pk_bf16(r[2], r[3]); w.z = cvt_pk_bf16(r[4], r[5]); w.w = cvt_pk_bf16(r[6], r[7]);
    *(u32x4*)(Z + (size_t)t * D + c) = w;
}
__device__ __forceinline__ void conv_pass(const bf16* __restrict__ Y1, const bf16* __restrict__ BG, bf16* __restrict__ Z, const float* __restrict__ cw, int G) {
    const int nitems = T * (D / 8), stride = G * NTHR;
    for (int it = blockIdx.x * NTHR + threadIdx.x; it < nitems; it += 4 * stride) {
        ConvIn v0 = conv_load(Y1, BG, it), v1, v2, v3;
        const bool h1 = it + stride < nitems, h2 = it + 2 * stride < nitems, h3 = it + 3 * stride < nitems;
        if (h1) v1 = conv_load(Y1, BG, it + stride);
        if (h2) v2 = conv_load(Y1, BG, it + 2 * stride);
        if (h3) v3 = conv_load(Y1, BG, it + 3 * stride);
        conv_store(Z, cw, it, v0);
        if (h1) conv_store(Z, cw, it + stride, v1);
        if (h2) conv_store(Z, cw, it + 2 * stride, v2);
        if (h3) conv_store(Z, cw, it + 3 * stride, v3);
    }
}

constexpr int N_PHASES = 16;
__global__ void __launch_bounds__(NTHR, 2) fwd_megakernel(Args a) {
    extern __shared__ __attribute__((aligned(16))) unsigned char lds_raw[];
    LAS unsigned char* lds = (LAS unsigned char*)lds_raw;
    cg::grid_group grid = cg::this_grid();
    const int G = gridDim.x; int bx = blockIdx.x; bool xl = false; unsigned half = 0u;
    unsigned char* ws = a.ws;
    const float* mod = (const float*)(ws + WS_MOD); const float* modc = (const float*)(ws + WS_MODC); const float* rope = (const float*)(ws + WS_ROPE);
    bf16* Win_t = (bf16*)(ws + WS_WIN); bf16* Wout_t = (bf16*)(ws + WS_WOUT); bf16* SCin_t = (bf16*)(ws + WS_SCIN); bf16* SCout_t = (bf16*)(ws + WS_SCOUT);
    bf16* KVC = (bf16*)(ws + WS_KVC); bf16* H = (bf16*)(ws + WS_H); bf16* BIG = (bf16*)(ws + WS_BIG); bf16* OB = (bf16*)(ws + WS_O); bf16* YB = (bf16*)(ws + WS_Y); bf16* XB = (bf16*)(ws + WS_XB);
    bf16* QKVB = (bf16*)a.out;
    const int lo = a.ph_lo, hi = a.ph_hi;
    volatile LAS unsigned* bst = (volatile LAS unsigned*)(lds + 131072 + 1024);
    if (threadIdx.x < 4) bst[threadIdx.x] = 0u;
    __syncthreads();
    if (lo == 0 && hi > 1) { if (blockIdx.x == 0) for (int w = threadIdx.x; w < XL_WORDS; w += NTHR) __hip_atomic_store((unsigned*)(ws + WS_CTL) + w, 0u, __ATOMIC_RELAXED, __HIP_MEMORY_SCOPE_AGENT); }
    XcdBarrier bar; bar.bar = (unsigned*)(ws + WS_CTL); bar.x = 0; bar.st = bst;
#define IN(k) (lo <= (k) && (k) < hi)
#define SEAM(k) do { if (IN(k) && IN((k) + 1)) { if (xl) xcd_half_barrier(bar, half); else xcd_barrier(bar); } } while (0)
#define SEAML(k) do { if (IN(k) && IN((k) + 1)) { if (xl) xcd_local_barrier(bar); else xcd_barrier(bar); } } while (0)

    if (IN(0)) { p0_prologue(a, lds, G); }
    if (IN(0) && IN(1)) {
        grid.sync();
        bar = xcd_barrier_post((unsigned*)(ws + WS_CTL), bst);
        xcd_barrier(bar);
        if (threadIdx.x == 0) {
            bool okc = (G == 256);
            for (int j = 0; j < 16; ++j) { const unsigned cnt = xb_ld((unsigned*)(ws + WS_CTL) + XB_XCNT(j)); okc = okc && (cnt == (j < 8 ? (unsigned)(G / 8) : 0u)); }
            okc = okc && (xb_ld((unsigned*)(ws + WS_CTL) + XB_TMO) == 0u);
            bst[3] = okc ? 1u : 0u;
        }
        __syncthreads();
        xl = bst[3] != 0u;
        if (xl) { bx = (int)bst[2] * 8 + (int)bar.x; half = bar.x >> 2; }
        const int wv = __builtin_amdgcn_readfirstlane(threadIdx.x >> 6);
        if (!xl) late_transposes(a, lds, bx * NWAVES + wv, G * NWAVES);
        else if (half == 1u) late_transposes(a, lds, ((bx >> 3) * 4 + ((bx & 7) - 4)) * NWAVES + wv, (G / 2) * NWAVES);
        __syncthreads();
    }
    if (IN(1)) {
        rowpass<false, false>(a.x, nullptr, nullptr, H, nullptr, nullptr, a.g_mix_pre, mod + 1024, mod + 0, 6144, T, SEQ, G, bx);
        if (!xl) rowpass<false, false>(a.ctx, nullptr, nullptr, H + (size_t)T * D, nullptr, nullptr, a.g_mix_pre, modc + 1024, modc + 0, 0, TC, TC, G, bx);
        else rowpass<false, false>(a.ctx + (size_t)half * CTXL * D, nullptr, nullptr, H + ((size_t)T + half * CTXL) * D, nullptr, nullptr, a.g_mix_pre, modc + 1024, modc + 0, 0, CTXL, CTXL, G / 2, (bx >> 3) * 4 + ((bx & 7) & 3));
    } SEAM(1);
    if (IN(1) && IN(2) && xl && half == 1u && threadIdx.x == 0) xb_add((unsigned*)(ws + WS_CTL) + XW_FLAG, 1u);
    if (IN(2)) {
        { pg8::Gemm g{H, Win_t, T, NIN0, D}; pg8::StaticOrder S; S.init(T, NIN0, G, bx);
          pg8::EpiInProj E{QKVB, NIN0, rope, SEQ};
          pg8::gemm_phase<pg8::EpiInProj, pg8::StaticOrder, true, true>(lds, g, S, E); }
        { pg8::Gemm g{H + (size_t)T * D, Win_t + (size_t)512 * D, TC, 256, D}; pg8::TailOrder S{G, bx, 2};
          pg8::EpiBf16 E{KVC, 256};
          pg8::gemm_phase<pg8::EpiBf16, pg8::TailOrder, true, true>(lds, g, S, E); }
    } SEAM(2);
    if (IN(3)) {
        __syncthreads();
        const int vbx = (G % 8 == 0) ? (bx % 8) * (G / 8) + bx / 8 : bx;
        for (int tb = vbx; tb < 256; tb += G) {
            attn_unit(lds, QKVB, KVC, OB, a.a_sink, ((tb >> 7) << 8) | ((tb & 127) << 1) | 0);
            attn_unit(lds, QKVB, KVC, OB, a.a_sink, ((tb >> 7) << 8) | ((tb & 127) << 1) | 1);
            gate_unit(lds, QKVB, OB, a.gm_v_norm, (const bf16*)(ws + WS_WSB), a.gm_bs, tb);
        }
    } SEAML(3);
    if (IN(4)) {
        pg8::Gemm g{OB, Wout_t, T, D, D}; pg8::StaticOrder S; S.init(T, D, G, bx); pg8::EpiBf16 E{YB, D};
        pg8::gemm_phase<pg8::EpiBf16, pg8::StaticOrder, true, true>(lds, g, S, E);
    } SEAML(4);
    if (IN(5)) {
        rowpass<false, true>(a.x, YB, XB, H, a.g_mix_post, mod + 2048, a.g_ffn_pre, mod + 4096, mod + 3072, 6144, T, SEQ, G, bx);
    } SEAML(5);
    if (IN(6) && xl && half == 0u) {
        if (threadIdx.x == 0) { unsigned* ctl_ = (unsigned*)(ws + WS_CTL); XB_SPIN(xb_ld(&ctl_[XW_FLAG]) < (unsigned)(G / 2), ctl_); __builtin_amdgcn_fence(__ATOMIC_ACQUIRE, "agent"); asm volatile("s_waitcnt vmcnt(0)" ::: "memory"); }
        __syncthreads();
    }
    if (IN(6)) {
        pg8::Gemm gu{H, (bf16*)(ws + WS_W13), T, 2 * DFF, D}; pg8::EpiPair<1> Eu{BIG, DFF, 1 << 30, nullptr, 0};
        pg8::Gemm gd{BIG, (bf16*)(ws + WS_W2), T, D, DFF}; pg8::EpiBf16 Ed{YB, D};
        if (G == 256) {
            { pg8::StaticOrder S; S.init(T, 2 * DFF, G, bx); S.window(0, 6); pg8::gemm_phase<pg8::EpiPair<1>, pg8::StaticOrder, true, true>(lds, gu, S, Eu); }
            if (xl) xcd_local_barrier(bar); else xcd_barrier(bar);
            { pg8::StaticOrder S; S.init(T, D, G, bx); S.window(0, 1); pg8::gemm_phase<pg8::EpiBf16, pg8::StaticOrder, true, true>(lds, gd, S, Ed); }
            if (xl) xcd_local_barrier(bar); else xcd_barrier(bar);
            { pg8::StaticOrder S; S.init(T, 2 * DFF, G, bx); S.window(6, 11); pg8::gemm_phase<pg8::EpiPair<1>, pg8::StaticOrder, true, true>(lds, gu, S, Eu); }
        } else {
            pg8::StaticOrder S; S.init(T, 2 * DFF, G, bx); pg8::gemm_phase<pg8::EpiPair<1>, pg8::StaticOrder, true, true>(lds, gu, S, Eu);
        }
    } SEAML(6);
    if (IN(7)) {
        pg8::Gemm gd{BIG, (bf16*)(ws + WS_W2), T, D, DFF}; pg8::EpiBf16 Ed{YB, D};
        pg8::StaticOrder S; S.init(T, D, G, bx, G == 256 ? 0 : 1); if (G == 256) S.window(1, 2);
        pg8::gemm_phase<pg8::EpiBf16, pg8::StaticOrder, true, true>(lds, gd, S, Ed);
    } SEAML(7);
    if (IN(8)) {
        rowpass<true, true>(XB, YB, XB, H, a.g_ffn_post, mod + 5120, a.g_mix_pre + D, mod + 2 * 6144 + 1024, mod + 2 * 6144 + 0, 6144, T, SEQ, G, bx);
    } SEAML(8);
    if (IN(9)) {
        pg8::Gemm g{H, SCin_t, T, 2048, D}; pg8::StaticOrder S; S.init(T, 2048, G, bx); pg8::EpiPair<0> E{YB, D, 1 << 30, nullptr, 0};
        pg8::gemm_phase<pg8::EpiPair<0>, pg8::StaticOrder, true, true>(lds, g, S, E);
    } SEAM(9);
    if (IN(10)) {
        pg8::Gemm g{H, SCin_t + (size_t)2048 * D, T, D, D}; pg8::StaticOrder S; S.init(T, D, G, bx); pg8::EpiConv E{YB, OB, a.sc_conv, D, SEQ};
        pg8::gemm_phase<pg8::EpiConv, pg8::StaticOrder, true, true>(lds, g, S, E);
    } SEAM(10);
    if (IN(11)) {
        pg8::Gemm g{OB, SCout_t, T, D, D}; pg8::StaticOrder S; S.init(T, D, G, bx); pg8::EpiBf16 E{YB, D};
        pg8::gemm_phase<pg8::EpiBf16, pg8::StaticOrder, true, true>(lds, g, S, E);
    } SEAML(11);
    if (IN(12)) {
        rowpass<true, true>(XB, YB, XB, H, a.g_mix_post + D, mod + 2 * 6144 + 2048, a.g_ffn_pre + D, mod + 2 * 6144 + 4096, mod + 2 * 6144 + 3072, 6144, T, SEQ, G, bx);
    } SEAML(12);
    if (IN(13)) {
        pg8::Gemm gu{H, (bf16*)(ws + WS_W13 + 11 * MiB), T, 2 * DFF, D}; pg8::EpiPair<1> Eu{BIG, DFF, 1 << 30, nullptr, 0};
        pg8::Gemm gd{BIG, (bf16*)(ws + WS_W2 + 6 * MiB), T, D, DFF}; pg8::EpiBf16 Ed{YB, D};
        if (G == 256) {
            { pg8::StaticOrder S; S.init(T, 2 * DFF, G, bx); S.window(0, 6); pg8::gemm_phase<pg8::EpiPair<1>, pg8::StaticOrder, true, true>(lds, gu, S, Eu); }
            if (xl) xcd_local_barrier(bar); else xcd_barrier(bar);
            { pg8::StaticOrder S; S.init(T, D, G, bx); S.window(0, 1); pg8::gemm_phase<pg8::EpiBf16, pg8::StaticOrder, true, true>(lds, gd, S, Ed); }
            if (xl) xcd_local_barrier(bar); else xcd_barrier(bar);
            { pg8::StaticOrder S; S.init(T, 2 * DFF, G, bx); S.window(6, 11); pg8::gemm_phase<pg8::EpiPair<1>, pg8::StaticOrder, true, true>(lds, gu, S, Eu); }
        } else {
            pg8::StaticOrder S; S.init(T, 2 * DFF, G, bx); pg8::gemm_phase<pg8::EpiPair<1>, pg8::StaticOrder, true, true>(lds, gu, S, Eu);
        }
    } SEAML(13);
    if (IN(14)) {
        pg8::Gemm gd{BIG, (bf16*)(ws + WS_W2 + 6 * MiB), T, D, DFF}; pg8::EpiBf16 Ed{YB, D};
        pg8::StaticOrder S; S.init(T, D, G, bx, G == 256 ? 0 : 1); if (G == 256) S.window(1, 2);
        pg8::gemm_phase<pg8::EpiBf16, pg8::StaticOrder, true, true>(lds, gd, S, Ed);
    } SEAML(14);
    if (IN(15)) {
        rowpass<true, false>(XB, YB, a.out, nullptr, a.g_ffn_post + D, mod + 2 * 6144 + 5120, nullptr, nullptr, nullptr, 6144, T, SEQ, G, bx);
    }
#undef IN
#undef SEAM
}

#ifndef MK_MULTI
#define MK_MULTI 0
#endif
extern "C" void kernel_launch(void* const* d_in, const int* in_sizes, int n_in, void* d_out, int out_size, void* d_ws, size_t ws_size, hipStream_t stream) {
    static int grid = 0;
    if (grid == 0) {
        if (n_in != 22 || out_size != T * D || ws_size < WS_END) { fprintf(stderr, "kernel_launch: unexpected shapes (n_in %d out %d ws %zu)\n", n_in, out_size, ws_size); grid = -1; return; }
        int dev = 0, cus = 0, per_cu = 0;
        hipGetDevice(&dev); hipDeviceGetAttribute(&cus, hipDeviceAttributeMultiprocessorCount, dev);
        hipFuncSetAttribute((const void*)fwd_megakernel, hipFuncAttributeMaxDynamicSharedMemorySize, LDS_BYTES);
        hipOccupancyMaxActiveBlocksPerMultiprocessor(&per_cu, (const void*)fwd_megakernel, NTHR, LDS_BYTES);
        if (per_cu < 1) { fprintf(stderr, "kernel_launch: occupancy query says %d blocks/CU\n", per_cu); per_cu = 1; }
        if (per_cu > 1) per_cu = 1;
        grid = cus * per_cu;
        (void)hipGetLastError();
    }
    if (grid < 0) return;
    Args a{};
    const float** ap = (const float**)&a;
    for (int i = 0; i < 22; ++i) ap[i] = (const float*)d_in[i];
    a.out = (float*)d_out; a.ws = (unsigned char*)d_ws;
#if MK_MULTI
    for (int p = 0; p < N_PHASES; ++p) { a.ph_lo = p; a.ph_hi = p + 1; hipLaunchKernelGGL(fwd_megakernel, dim3(grid), dim3(NTHR), LDS_BYTES, stream, a); }
#else
    a.ph_lo = 0; a.ph_hi = N_PHASES;
    void* args[] = {&a};
    hipError_t e = hipLaunchCooperativeKernel((const void*)fwd_megakernel, dim3(grid), dim3(NTHR), args, LDS_BYTES, stream);
    if (e != hipSuccess) fprintf(stderr, "cooperative launch failed: %s (grid %d)\n", hipGetErrorString(e), grid);
#endif
}
```
